# Optimizing an MI355X kernel written in HIP

```python
import jax, jax.numpy as jnp
from jax import lax
import numpy as np

D_MODEL = 1024
BATCH = 16
SEQ = 2048
DEPTH = 2

N_MIXERS = 2
N_RET_LAYERS = (DEPTH + 1) // 2
N_MLA_LAYERS = DEPTH // 2

D_FF = 4 * D_MODEL
RMS_EPS = 1e-6
GN_EPS = 1e-5
ROPE_THETA = 10000.0
N_ADA = 6

RET_HEADS = D_MODEL // 256
RET_DK = D_MODEL // RET_HEADS
RET_DV = 2 * RET_DK
RET_CHUNK = 128
RET_IN_COLS = 2 * RET_HEADS * RET_DK + 2 * RET_HEADS * RET_DV

MLA_HEADS = D_MODEL // 128
MLA_NOPE = 128
MLA_ROPE = 64
MLA_V = 128
MLA_DQK = MLA_NOPE + MLA_ROPE
MLA_Q_LORA = 3 * D_MODEL // 8
MLA_KV_LORA = D_MODEL // 4
MLA_IN_COLS = MLA_Q_LORA + MLA_KV_LORA + MLA_ROPE
MLA_QBLOCK = 128

kernel_name = "bidir_retention_mla_interleaved_sqrelu_adaln"

F32 = jnp.float32


def rmsnorm(t, w):
    t32 = t.astype(F32)
    y = t32 * lax.rsqrt(jnp.mean(t32 * t32, axis=-1, keepdims=True) + RMS_EPS)
    return (y * w.astype(F32)).astype(t.dtype)


def rope(t, positions):
    d = t.shape[-1]
    inv = ROPE_THETA ** (-jnp.arange(0, d, 2, dtype=F32) / d)
    ang = positions.astype(F32)[..., None] * inv
    cos = jnp.cos(ang)[:, :, None, :]
    sin = jnp.sin(ang)[:, :, None, :]
    t32 = t.astype(F32)
    t1, t2 = t32[..., : d // 2], t32[..., d // 2:]
    return jnp.concatenate([t1 * cos - t2 * sin, t1 * sin + t2 * cos], axis=-1).astype(t.dtype)


def retention_one_direction(q, k, v, log_gamma, strict):
    b, s, h, dk = q.shape
    dv = v.shape[-1]
    n_chunks = s // RET_CHUNK

    def chunks(t):
        return t.reshape(b, n_chunks, RET_CHUNK, h, t.shape[-1]).transpose(1, 0, 3, 2, 4)

    qc, kc, vc = chunks(q), chunks(k), chunks(v)
    pos = jnp.arange(RET_CHUNK, dtype=F32)
    diff = pos[:, None] - pos[None, :]
    mask = (diff > 0) if strict else (diff >= 0)
    lg = log_gamma.astype(F32)
    intra_decay = jnp.where(mask[None], jnp.exp(jnp.where(mask[None], diff[None] * lg[:, None, None], 0.0)), 0.0)
    cross_decay = jnp.exp((pos + 1.0)[None, :] * lg[:, None])[None, :, :, None]
    state_decay = jnp.exp((RET_CHUNK - 1.0 - pos)[None, :] * lg[:, None])[None, :, :, None]
    chunk_decay = jnp.exp(RET_CHUNK * lg)[None, :, None, None]

    def step(state, inp):
        qi, ki, vi = inp
        scores = jnp.einsum('bhnd,bhmd->bhnm', qi, ki) * intra_decay
        out = jnp.einsum('bhnm,bhmv->bhnv', scores, vi)
        out = out + jnp.einsum('bhnd,bhdv->bhnv', qi, state) * cross_decay
        state = state * chunk_decay + jnp.einsum('bhmd,bhmv->bhdv', ki * state_decay, vi)
        return state, out

    state0 = jnp.zeros((b, h, dk, dv), F32)
    _, out = lax.scan(step, state0, (qc, kc, vc))
    return out.transpose(1, 0, 3, 2, 4).reshape(b, s, h, dv)


def retention_mixer(hdn, positions, w_in, logit_fwd, logit_bwd, gn_w, w_out):
    b, s, _ = hdn.shape
    hk = RET_HEADS * RET_DK
    hv = RET_HEADS * RET_DV
    proj = hdn @ w_in
    q, k, v, g = jnp.split(proj, [hk, 2 * hk, 2 * hk + hv], axis=-1)
    q = rope(q.reshape(b, s, RET_HEADS, RET_DK), positions).astype(F32)
    k = rope(k.reshape(b, s, RET_HEADS, RET_DK), positions).astype(F32) * (RET_DK ** -0.5)
    v = v.reshape(b, s, RET_HEADS, RET_DV).astype(F32)
    lg_f = jax.nn.log_sigmoid(logit_fwd.astype(F32))
    lg_b = jax.nn.log_sigmoid(logit_bwd.astype(F32))
    y_f = retention_one_direction(q, k, v, lg_f, strict=False)
    y_b = retention_one_direction(q[:, ::-1], k[:, ::-1], v[:, ::-1], lg_b, strict=True)[:, ::-1]
    y = y_f + y_b
    mu = jnp.mean(y, axis=-1, keepdims=True)
    var = jnp.mean(jnp.square(y - mu), axis=-1, keepdims=True)
    y = ((y - mu) * lax.rsqrt(var + GN_EPS)).reshape(b, s, hv) * gn_w.astype(F32)
    y = jax.nn.silu(g.astype(F32)) * y
    return y.astype(hdn.dtype) @ w_out


def mla_mixer(hdn, positions, w_in, q_norm, w_uq, kv_norm, w_ukv, w_out):
    b, s, _ = hdn.shape
    c_q, c_kv, k_rope = jnp.split(hdn @ w_in, [MLA_Q_LORA, MLA_Q_LORA + MLA_KV_LORA], axis=-1)
    q = (rmsnorm(c_q, q_norm) @ w_uq).reshape(b, s, MLA_HEADS, MLA_DQK)
    q = jnp.concatenate([q[..., :MLA_NOPE], rope(q[..., MLA_NOPE:], positions)], axis=-1)
    kv = (rmsnorm(c_kv, kv_norm) @ w_ukv).reshape(b, s, MLA_HEADS, MLA_NOPE + MLA_V)
    k_nope, v = kv[..., :MLA_NOPE], kv[..., MLA_NOPE:]
    k_rope = rope(k_rope[:, :, None, :], positions)
    k = jnp.concatenate([k_nope, jnp.broadcast_to(k_rope, (b, s, MLA_HEADS, MLA_ROPE))], axis=-1)
    scale = MLA_DQK ** -0.5
    n_blk = s // MLA_QBLOCK
    q_blocks = q.reshape(b, n_blk, MLA_QBLOCK, MLA_HEADS, MLA_DQK).transpose(1, 0, 2, 3, 4)

    def attend(qi):
        sc = jnp.einsum('bqhd,bkhd->bhqk', qi, k, preferred_element_type=F32) * scale
        p = jax.nn.softmax(sc, axis=-1)
        return jnp.einsum('bhqk,bkhd->bqhd', p.astype(v.dtype), v)

    o = lax.map(attend, q_blocks)
    o = o.transpose(1, 0, 2, 3, 4).reshape(b, s, MLA_HEADS * MLA_V)
    return o @ w_out


def setup_inputs(seed: int = 0) -> dict:
    key = jax.random.key(seed)
    ks = jax.random.split(key, 24)

    def w(k, shape, fan_in, s=1.0):
        return jax.random.normal(k, shape, F32) * (s * fan_in ** -0.5)

    def gain(k, shape):
        return 1.0 + 0.05 * jax.random.normal(k, shape, F32)

    base_logit = jnp.asarray(np.log(2.0 ** (5.0 + np.arange(RET_HEADS)) - 1.0), F32)
    x = jax.random.normal(ks[0], (BATCH, SEQ, D_MODEL), F32)
    c = jax.random.normal(ks[1], (BATCH, D_MODEL), F32)
    offsets = jax.random.randint(ks[2], (BATCH, 1), 0, 4096, dtype=jnp.int32)
    positions = offsets + jnp.arange(SEQ, dtype=jnp.int32)[None, :]
    return {
        "x": x,
        "c": c,
        "positions": positions,
        "norm_w": gain(ks[3], (DEPTH, 4, D_MODEL)),
        "ada_w": w(ks[4], (DEPTH, D_MODEL, N_ADA * D_MODEL), D_MODEL, 0.5),
        "ada_b": 0.02 * jax.random.normal(ks[5], (DEPTH, N_ADA * D_MODEL), F32),
        "ret_w_in": w(ks[6], (N_RET_LAYERS, D_MODEL, RET_IN_COLS), D_MODEL),
        "ret_decay_logit_fwd": base_logit + 0.1 * jax.random.normal(ks[7], (N_RET_LAYERS, RET_HEADS), F32),
        "ret_decay_logit_bwd": base_logit + 0.1 * jax.random.normal(ks[8], (N_RET_LAYERS, RET_HEADS), F32),
        "ret_gn_w": gain(ks[9], (N_RET_LAYERS, RET_HEADS * RET_DV)),
        "ret_w_out": w(ks[10], (N_RET_LAYERS, RET_HEADS * RET_DV, D_MODEL), RET_HEADS * RET_DV),
        "mla_w_in": w(ks[11], (N_MLA_LAYERS, D_MODEL, MLA_IN_COLS), D_MODEL),
        "mla_q_norm": gain(ks[12], (N_MLA_LAYERS, MLA_Q_LORA)),
        "mla_w_uq": w(ks[13], (N_MLA_LAYERS, MLA_Q_LORA, MLA_HEADS * MLA_DQK), MLA_Q_LORA),
        "mla_kv_norm": gain(ks[14], (N_MLA_LAYERS, MLA_KV_LORA)),
        "mla_w_ukv": w(ks[15], (N_MLA_LAYERS, MLA_KV_LORA, MLA_HEADS * (MLA_NOPE + MLA_V)), MLA_KV_LORA),
        "mla_w_out": w(ks[16], (N_MLA_LAYERS, MLA_HEADS * MLA_V, D_MODEL), MLA_HEADS * MLA_V),
        "mlp_w1": w(ks[17], (DEPTH, D_MODEL, D_FF), D_MODEL),
        "mlp_w2": w(ks[18], (DEPTH, D_FF, D_MODEL), D_FF),
    }


def reference(x, c, positions, norm_w, ada_w, ada_b, ret_w_in, ret_decay_logit_fwd,
              ret_decay_logit_bwd, ret_gn_w, ret_w_out, mla_w_in, mla_q_norm, mla_w_uq,
              mla_kv_norm, mla_w_ukv, mla_w_out, mlp_w1, mlp_w2):
    c_act = jax.nn.silu(c)
    for i in range(DEPTH):
        mod = c_act @ ada_w[i] + ada_b[i]
        sh_a, sc_a, g_a, sh_m, sc_m, g_m = [m[:, None, :] for m in jnp.split(mod, N_ADA, axis=-1)]
        hdn = rmsnorm(x, norm_w[i, 0]) * (1.0 + sc_a) + sh_a
        j = i // N_MIXERS
        if i % N_MIXERS == 0:
            y = retention_mixer(hdn, positions, ret_w_in[j], ret_decay_logit_fwd[j],
                                ret_decay_logit_bwd[j], ret_gn_w[j], ret_w_out[j])
        else:
            y = mla_mixer(hdn, positions, mla_w_in[j], mla_q_norm[j], mla_w_uq[j],
                          mla_kv_norm[j], mla_w_ukv[j], mla_w_out[j])
        x = x + g_a * rmsnorm(y, norm_w[i, 1])
        hdn = rmsnorm(x, norm_w[i, 2]) * (1.0 + sc_m) + sh_m
        y = jnp.square(jax.nn.relu(hdn @ mlp_w1[i])) @ mlp_w2[i]
        x = x + g_m * rmsnorm(y, norm_w[i, 3])
    return x
```

```cpp
#include <hip/hip_runtime.h>
#include <hip/hip_cooperative_groups.h>
#include <cstdio>
#include <cstdint>
namespace cg = cooperative_groups;

#ifndef MULTI_LAUNCH
#define MULTI_LAUNCH 0
#endif

#define LAS __attribute__((address_space(3)))
typedef unsigned short bf16_t;
typedef short bf16x8 __attribute__((ext_vector_type(8)));
typedef short s16x4 __attribute__((ext_vector_type(4)));
typedef float f32x4 __attribute__((ext_vector_type(4)));
typedef float f32x2 __attribute__((ext_vector_type(2)));
typedef float f32x16 __attribute__((ext_vector_type(16)));
typedef unsigned u32x4 __attribute__((ext_vector_type(4)));
typedef unsigned u32x2 __attribute__((ext_vector_type(2)));

constexpr int T_TOK = 32768, DM = 1024, NB = 16, SEQ = 2048;
constexpr size_t MiB = 1u << 20;
constexpr size_t WS_MOD = 0;
constexpr size_t WS_SSQQ = 1 * MiB;
constexpr size_t WS_SSQKV = 1 * MiB + 256 * 1024;
constexpr size_t WS_DEC = 1 * MiB + 512 * 1024;
constexpr size_t WS_GN = 2 * MiB;
constexpr size_t WS_RWIN = 4 * MiB;
constexpr size_t WS_RWOUT = 16 * MiB;
constexpr size_t WS_MWIN = 20 * MiB;
constexpr size_t WS_MWUQ = 22 * MiB;
constexpr size_t WS_MWUKV = 24 * MiB;
constexpr size_t WS_MWOUT = 25 * MiB;
constexpr size_t WS_W1 = 28 * MiB;
constexpr size_t WS_W2 = 44 * MiB;
constexpr size_t WS_HDN = 60 * MiB;
constexpr size_t WS_R1 = 124 * MiB;
constexpr size_t WS_R2 = 252 * MiB;
constexpr size_t WS_R3 = 380 * MiB;
constexpr size_t WS_END = 508 * MiB;

constexpr int LDS_BYTES = 132096;

struct Args { const float* in[19]; float* out; unsigned char* ws; int j_lo, j_hi; };
typedef const __attribute__((address_space(4))) Args* ArgsP;

__device__ __forceinline__ unsigned cvt_pk_bf16(float lo, float hi) { unsigned r; asm volatile("v_cvt_pk_bf16_f32 %0, %1, %2" : "=v"(r) : "v"(lo), "v"(hi)); return r; }
__device__ __forceinline__ float bf2f(unsigned h) { return __uint_as_float(h << 16); }
__device__ __forceinline__ u32x4 pack8(f32x4 a, f32x4 b) { u32x4 w; w.x = cvt_pk_bf16(a[0], a[1]); w.y = cvt_pk_bf16(a[2], a[3]); w.z = cvt_pk_bf16(b[0], b[1]); w.w = cvt_pk_bf16(b[2], b[3]); return w; }
__device__ __forceinline__ float wave_sum(float v) {
#pragma unroll
    for (int o = 1; o < 64; o <<= 1) v += __shfl_xor(v, o);
    return v;
}
__device__ const float INVF_RET[128] = {1.000000000e+00f, 9.305720329e-01f, 8.659643531e-01f, 8.058421612e-01f, 7.498942018e-01f, 6.978305578e-01f, 6.493816376e-01f, 6.042963862e-01f, 5.623413324e-01f, 5.232990980e-01f, 4.869675338e-01f, 4.531583786e-01f, 4.216965139e-01f, 3.924189806e-01f, 3.651741147e-01f, 3.398208320e-01f, 3.162277639e-01f, 2.942727208e-01f, 2.738419771e-01f, 2.548296750e-01f, 2.371373773e-01f, 2.206734121e-01f, 2.053525001e-01f, 1.910952926e-01f, 1.778279394e-01f, 1.654817164e-01f, 1.539926529e-01f, 1.433012635e-01f, 1.333521456e-01f, 1.240937784e-01f, 1.154781953e-01f, 1.074607819e-01f, 1.000000015e-01f, 9.305720776e-02f, 8.659642935e-02f, 8.058422059e-02f, 7.498942316e-02f, 6.978306174e-02f, 6.493816525e-02f, 6.042964011e-02f, 5.623413250e-02f, 5.232991278e-02f, 4.869675264e-02f, 4.531583562e-02f, 4.216964915e-02f, 3.924189880e-02f, 3.651741147e-02f, 3.398208320e-02f, 3.162277490e-02f, 2.942727134e-02f, 2.738419548e-02f, 2.548296750e-02f, 2.371373773e-02f, 2.206734009e-02f, 2.053525113e-02f, 1.910953037e-02f, 1.778279431e-02f, 1.654817164e-02f, 1.539926510e-02f, 1.433012541e-02f, 1.333521400e-02f, 1.240937784e-02f, 1.154781971e-02f, 1.074607857e-02f, 9.999999776e-03f, 9.305720218e-03f, 8.659643121e-03f, 8.058422245e-03f, 7.498942316e-03f, 6.978305988e-03f, 6.493816152e-03f, 6.042963825e-03f, 5.623413250e-03f, 5.232991185e-03f, 4.869675264e-03f, 4.531583749e-03f, 4.216964822e-03f, 3.924189601e-03f, 3.651741194e-03f, 3.398208413e-03f, 3.162277630e-03f, 2.942727180e-03f, 2.738419687e-03f, 2.548296703e-03f, 2.371373819e-03f, 2.206734149e-03f, 2.053525066e-03f, 1.910952968e-03f, 1.778279431e-03f, 1.654817141e-03f, 1.539926510e-03f, 1.433012541e-03f, 1.333521446e-03f, 1.240937738e-03f, 1.154782018e-03f, 1.074607833e-03f, 1.000000047e-03f, 9.305720450e-04f, 8.659643354e-04f, 8.058421663e-04f, 7.498941850e-04f, 6.978305755e-04f, 6.493816036e-04f, 6.042963942e-04f, 5.623413017e-04f, 5.232990952e-04f, 4.869675322e-04f, 4.531583691e-04f, 4.216965172e-04f, 3.924189659e-04f, 3.651741135e-04f, 3.398208355e-04f, 3.162277571e-04f, 2.942727297e-04f, 2.738419571e-04f, 2.548296761e-04f, 2.371373703e-04f, 2.206734061e-04f, 2.053525095e-04f, 1.910952997e-04f, 1.778279402e-04f, 1.654817170e-04f, 1.539926598e-04f, 1.433012512e-04f, 1.333521504e-04f, 1.240937709e-04f, 1.154782003e-04f, 1.074607862e-04f};
__device__ const float INVF_MLA[32] = {1.000000000e+00f, 7.498942018e-01f, 5.623413324e-01f, 4.216965139e-01f, 3.162277639e-01f, 2.371373773e-01f, 1.778279394e-01f, 1.333521456e-01f, 1.000000015e-01f, 7.498942316e-02f, 5.623413250e-02f, 4.216964915e-02f, 3.162277490e-02f, 2.371373773e-02f, 1.778279431e-02f, 1.333521400e-02f, 9.999999776e-03f, 7.498942316e-03f, 5.623413250e-03f, 4.216964822e-03f, 3.162277630e-03f, 2.371373819e-03f, 1.778279431e-03f, 1.333521446e-03f, 1.000000047e-03f, 7.498941850e-04f, 5.623413017e-04f, 4.216965172e-04f, 3.162277571e-04f, 2.371373703e-04f, 1.778279402e-04f, 1.333521504e-04f};
__device__ __forceinline__ void sincos_f(float x, float& s, float& c) {
    const float n = rintf(x * 0.636619772f);
    float r = fmaf(-n, 1.57079637050628662109375f, x); r = fmaf(-n, -4.37113900018624283e-8f, r); r = fmaf(-n, -1.7151245100059e-15f, r);
    const int q = ((int)n) & 3; const float r2 = r * r;
    const float sp = fmaf(fmaf(fmaf(-1.9515295891e-4f, r2, 8.3321608736e-3f), r2, -1.6666654611e-1f) * r2, r, r);
    const float cp = fmaf(fmaf(fmaf(2.443315711809948e-5f, r2, -1.388731625493765e-3f), r2, 4.166664568298827e-2f), r2 * r2, fmaf(-0.5f, r2, 1.0f));
    s = (q == 0) ? sp : (q == 1) ? cp : (q == 2) ? -sp : -cp;
    c = (q == 0) ? cp : (q == 1) ? -sp : (q == 2) ? -cp : sp;
}

constexpr int BM = 256, BK = 64, HALF = 128, HTB = HALF * BK * 2, NXCD = 8, WGM = 8;
__device__ __forceinline__ int lds_byte(int r, int c) { const int st = (r >> 4) * 2 + (c >> 5), rr = r & 15, cc = c & 31, ob = rr * 64 + cc * 2; return st * 1024 + (ob ^ (((ob >> 9) & 1) << 5)); }
__device__ __forceinline__ void stage_rc(int b, int& R, int& C) { const int st = b / 1024, sb = b % 1024, swz = sb ^ (((sb >> 9) & 1) << 5); R = (st >> 1) * 16 + swz / 64; C = (st & 1) * 32 + (swz % 64) / 2; }
__device__ __forceinline__ int perm32(int rho) { const int n = rho >> 4, i = rho & 15; return 8 * (i >> 2) + 4 * n + (i & 3); }

struct Unit { int z, pm, pn; };
enum { EPI_RETQK = 0, EPI_STORE = 1, EPI_RELU2 = 2, EPI_SDECAY = 3, EPI_OY = 4, EPI_GATE = 5, EPI_WIN = 6, EPI_UQ = 7, EPI_UKV = 8 };
struct GemmJob {
    const bf16_t* A; const bf16_t* Bt; int lda, ldb, K, nM, nN, nZ;
    long zAh, zAl, zBh, zBl; int zdiv;
    int epi; int var;
};
struct EpiPtr { bf16_t* out; bf16_t* out2; int ldc; long zC; const float* f0; const float* f1; float* s0; float* s1; const bf16_t* b0; };
struct Sched {
    int nM, nN, nwg, per, G, c;
    __device__ __forceinline__ void init(int nZ, int nM_, int nN_, int G_, int c_) { nM = nM_; nN = nN_; per = nM * nN; nwg = nZ * per; G = G_; c = c_; }
    __device__ __forceinline__ bool next(int i, Unit& u) const {
        const long L = (long)i * G + c; if (L >= nwg) return false;
        int wgid = (int)L; { const int q = nwg / NXCD, r = nwg % NXCD, xcd = wgid % NXCD, off = wgid / NXCD; wgid = (xcd < r ? xcd * (q + 1) : r * (q + 1) + (xcd - r) * q) + off; }
        u.z = wgid / per; const int w = wgid % per;
        const int nig = WGM * nN, gid = w / nig, fm = gid * WGM, gsz = (nM - fm) < WGM ? (nM - fm) : WGM;
        u.pm = fm + ((w % nig) % gsz); u.pn = (w % nig) / gsz; return true;
    }
};

typedef f32x4 Acc[2][2][4][2];

#ifndef EPI_MASK
#define EPI_MASK 0x1ff
#endif
#define EPI_FENCE() asm volatile("" ::: "memory")
__device__ __forceinline__ void epilogue(const Acc& acc, const Unit& u, int wr, int wc, int fr_in, int fq_in, const int epi, const int var, ArgsP ap) {
    unsigned char* ws = ap->ws;
    int fr = fr_in, fq = fq_in; asm volatile("" : "+v"(fr), "+v"(fq));
    const int rowb = u.pm * BM + wr * 64 + fr;
    const int colb = wc * 32 + 8 * fq;
    EpiPtr J{};
    switch (epi) {
    case EPI_RETQK: { if (!((EPI_MASK >> EPI_RETQK) & 1)) break;
        J.out = (bf16_t*)(ws + WS_R1); J.f0 = (const float*)(ws + WS_R3);
        const int kpart = u.pn >> 2, h = u.pn & 3; const float sc = kpart ? 0.0625f : 1.0f;
#pragma unroll
        for (int ai = 0; ai < 2; ++ai)
#pragma unroll
            for (int m = 0; m < 4; ++m) {
                const int row = rowb + ai * HALF + m * 16; const int b = row >> 11, s = row & 2047;
                bf16_t* dst = J.out + ((size_t)(b * 2 + kpart) * 2048 + s) * 1024 + h * 256 + colb;
                const f32x4* tp = (const f32x4*)(J.f0 + ((size_t)row * 128 + colb) * 2);
                const f32x4 t0 = tp[0], t1 = tp[1], t2 = tp[2], t3 = tp[3];
                const f32x4 a0 = acc[ai][0][m][0], a1 = acc[ai][0][m][1], b0 = acc[ai][1][m][0], b1 = acc[ai][1][m][1];
                f32x4 o0, o1, p0, p1;
                o0[0] = (a0[0] * t0[0] - b0[0] * t0[1]) * sc; p0[0] = (a0[0] * t0[1] + b0[0] * t0[0]) * sc;
                o0[1] = (a0[1] * t0[2] - b0[1] * t0[3]) * sc; p0[1] = (a0[1] * t0[3] + b0[1] * t0[2]) * sc;
                o0[2] = (a0[2] * t1[0] - b0[2] * t1[1]) * sc; p0[2] = (a0[2] * t1[1] + b0[2] * t1[0]) * sc;
                o0[3] = (a0[3] * t1[2] - b0[3] * t1[3]) * sc; p0[3] = (a0[3] * t1[3] + b0[3] * t1[2]) * sc;
                o1[0] = (a1[0] * t2[0] - b1[0] * t2[1]) * sc; p1[0] = (a1[0] * t2[1] + b1[0] * t2[0]) * sc;
                o1[1] = (a1[1] * t2[2] - b1[1] * t2[3]) * sc; p1[1] = (a1[1] * t2[3] + b1[1] * t2[2]) * sc;
                o1[2] = (a1[2] * t3[0] - b1[2] * t3[1]) * sc; p1[2] = (a1[2] * t3[1] + b1[2] * t3[0]) * sc;
                o1[3] = (a1[3] * t3[2] - b1[3] * t3[3]) * sc; p1[3] = (a1[3] * t3[3] + b1[3] * t3[2]) * sc;
                *(u32x4*)dst = pack8(o0, o1); *(u32x4*)(dst + 128) = pack8(p0, p1);
                EPI_FENCE();
            }
    } break;
    case EPI_STORE: case EPI_RELU2: { if (!((EPI_MASK >> EPI_STORE) & 1)) break;
        if (var == 0) { J.out = (bf16_t*)(ws + WS_R2); J.ldc = T_TOK; } else if (var == 1) { J.out = (bf16_t*)(ws + WS_R3); J.ldc = 1024; } else if (var == 2) { J.out = (bf16_t*)(ws + WS_R1); J.ldc = 1024; } else { J.out = (bf16_t*)(ws + WS_R1); J.ldc = 4096; } J.zC = 0;
        bf16_t* base = J.out + (size_t)u.z * J.zC + u.pn * BM + colb;
#pragma unroll
        for (int ai = 0; ai < 2; ++ai)
#pragma unroll
            for (int m = 0; m < 4; ++m) {
                bf16_t* rowp = base + (size_t)(rowb + ai * HALF + m * 16) * J.ldc;
#pragma unroll
                for (int bj = 0; bj < 2; ++bj) {
                    f32x4 v0 = acc[ai][bj][m][0], v1 = acc[ai][bj][m][1];
                    if (epi == EPI_RELU2) {
#pragma unroll
                        for (int i = 0; i < 4; ++i) { const float x0 = fmaxf(v0[i], 0.f), x1 = fmaxf(v1[i], 0.f); v0[i] = x0 * x0; v1[i] = x1 * x1; }
                    }
                    *(u32x4*)(rowp + bj * HALF) = pack8(v0, v1);
                }
            }
    } break;
    case EPI_SDECAY: { if (!((EPI_MASK >> EPI_SDECAY) & 1)) break;
        J.out = (bf16_t*)(ws + WS_R3); J.ldc = 2048; J.zC = (long)2048 * 2048; J.f0 = (const float*)(ws + WS_DEC);
        const int h = u.z & 3;
        const float lf = J.f0[h], lb = J.f0[4 + h];
        bf16_t* base = J.out + (size_t)u.z * J.zC + u.pn * BM + colb;
#pragma unroll
        for (int ai = 0; ai < 2; ++ai)
#pragma unroll
            for (int m = 0; m < 4; ++m) {
                const int row = rowb + ai * HALF + m * 16;
                bf16_t* rowp = base + (size_t)row * J.ldc;
#pragma unroll
                for (int bj = 0; bj < 2; ++bj) {
                    const int col = u.pn * BM + bj * HALF + colb;
                    f32x4 v0 = acc[ai][bj][m][0], v1 = acc[ai][bj][m][1];
#pragma unroll
                    for (int i = 0; i < 4; ++i) {
                        const int d0 = row - (col + i), d1 = row - (col + 4 + i);
                        v0[i] *= __builtin_amdgcn_exp2f(d0 >= 0 ? lf * (float)d0 : lb * (float)(-d0));
                        v1[i] *= __builtin_amdgcn_exp2f(d1 >= 0 ? lf * (float)d1 : lb * (float)(-d1));
                    }
                    *(u32x4*)(rowp + bj * HALF) = pack8(v0, v1);
                }
            }
    } break;
    case EPI_OY: { if (!((EPI_MASK >> EPI_OY) & 1)) break;
        J.out = (bf16_t*)(ws + WS_R1); J.s0 = (float*)(ws + WS_GN);
        const int b = var + (u.z >> 2), h = u.z & 3;
#pragma unroll
        for (int ai = 0; ai < 2; ++ai)
#pragma unroll
            for (int m = 0; m < 4; ++m) {
                const int row = rowb + ai * HALF + m * 16; const size_t tok = (size_t)b * 2048 + row;
                bf16_t* rowp = J.out + tok * 2048 + h * 512 + u.pn * BM + colb;
                float s1 = 0.f, s2 = 0.f;
#pragma unroll
                for (int bj = 0; bj < 2; ++bj) {
                    const f32x4 v0 = acc[ai][bj][m][0], v1 = acc[ai][bj][m][1];
#pragma unroll
                    for (int i = 0; i < 4; ++i) { s1 += v0[i] + v1[i]; s2 += v0[i] * v0[i] + v1[i] * v1[i]; }
                    *(u32x4*)(rowp + bj * HALF) = pack8(v0, v1);
                }
                s1 += __shfl_xor(s1, 16); s1 += __shfl_xor(s1, 32); s2 += __shfl_xor(s2, 16); s2 += __shfl_xor(s2, 32);
                if (fq == 0) { float* g = J.s0 + (tok * 4 + h) * 2; atomicAdd(g, s1); atomicAdd(g + 1, s2); }
                EPI_FENCE();
            }
    } break;
    case EPI_GATE: { if (!((EPI_MASK >> EPI_GATE) & 1)) break;
        J.out = (bf16_t*)(ws + WS_R1); J.f0 = (const float*)(ws + WS_GN); J.f1 = ap->in[9];
        const int h = u.pn >> 1;
#pragma unroll
        for (int ai = 0; ai < 2; ++ai)
#pragma unroll
            for (int m = 0; m < 4; ++m) {
                const size_t tok = (size_t)(rowb + ai * HALF + m * 16);
                const f32x2 st = *(const f32x2*)(J.f0 + (tok * 4 + h) * 2);
                const float mu = st[0] * (1.0f / 512.0f); const float var = st[1] * (1.0f / 512.0f) - mu * mu;
                const float rstd = 1.0f / sqrtf(fmaxf(var, 0.f) + 1e-5f);
                bf16_t* rowp = J.out + tok * 2048 + u.pn * BM + colb;
#pragma unroll
                for (int bj = 0; bj < 2; ++bj) {
                    const u32x4 yv = *(const u32x4*)(rowp + bj * HALF);
                    const f32x4 g0 = *(const f32x4*)(J.f1 + u.pn * BM + bj * HALF + colb), g1 = *(const f32x4*)(J.f1 + u.pn * BM + bj * HALF + colb + 4);
                    const f32x4 a0 = acc[ai][bj][m][0], a1 = acc[ai][bj][m][1];
                    f32x4 y0, y1, o0, o1;
                    y0[0] = bf2f(yv.x & 0xffffu); y0[1] = bf2f(yv.x >> 16); y0[2] = bf2f(yv.y & 0xffffu); y0[3] = bf2f(yv.y >> 16);
                    y1[0] = bf2f(yv.z & 0xffffu); y1[1] = bf2f(yv.z >> 16); y1[2] = bf2f(yv.w & 0xffffu); y1[3] = bf2f(yv.w >> 16);
#pragma unroll
                    for (int i = 0; i < 4; ++i) {
                        const float sg0 = a0[i] / (1.0f + __expf(-a0[i])), sg1 = a1[i] / (1.0f + __expf(-a1[i]));
                        o0[i] = sg0 * ((y0[i] - mu) * rstd * g0[i]); o1[i] = sg1 * ((y1[i] - mu) * rstd * g1[i]);
                    }
                    *(u32x4*)(rowp + bj * HALF) = pack8(o0, o1);
                    EPI_FENCE();
                }
            }
    } break;
    case EPI_WIN: { if (!((EPI_MASK >> EPI_WIN) & 1)) break;
        J.out = (bf16_t*)(ws + WS_R3); J.s0 = (float*)(ws + WS_SSQQ); J.s1 = (float*)(ws + WS_SSQKV);
#pragma unroll
        for (int ai = 0; ai < 2; ++ai)
#pragma unroll
            for (int m = 0; m < 4; ++m) {
                const int row = rowb + ai * HALF + m * 16;
                bf16_t* rowp = J.out + (size_t)row * 768 + u.pn * BM + colb;
                float sq = 0.f, skv = 0.f;
#pragma unroll
                for (int bj = 0; bj < 2; ++bj) {
                    const f32x4 v0 = acc[ai][bj][m][0], v1 = acc[ai][bj][m][1];
                    float s = 0.f;
#pragma unroll
                    for (int i = 0; i < 4; ++i) s += v0[i] * v0[i] + v1[i] * v1[i];
                    const int reg = u.pn * 2 + bj;
                    if (reg < 3) sq += s; else if (reg < 5) skv += s;
                    *(u32x4*)(rowp + bj * HALF) = pack8(v0, v1);
                }
                sq += __shfl_xor(sq, 16); sq += __shfl_xor(sq, 32); skv += __shfl_xor(skv, 16); skv += __shfl_xor(skv, 32);
                if (fq == 0) { if (u.pn < 2) atomicAdd(J.s0 + row, sq); if (u.pn > 0) atomicAdd(J.s1 + row, skv); }
                EPI_FENCE();
            }
    } break;
    case EPI_UQ: { if (!((EPI_MASK >> EPI_UQ) & 1)) break;
        J.out = (bf16_t*)(ws + WS_R1); J.f0 = (const float*)(ws + WS_SSQQ); J.f1 = (const float*)(ws + WS_R3 + 64 * MiB);
#pragma unroll
        for (int ai = 0; ai < 2; ++ai)
#pragma unroll
            for (int m = 0; m < 4; ++m) {
                const int row = rowb + ai * HALF + m * 16;
                const float rstd = 1.0f / sqrtf(J.f0[row] * (1.0f / 384.0f) + 1e-6f);
                bf16_t* qrow = J.out + (size_t)row * 1536;
                if (u.pn < 4) {
#pragma unroll
                    for (int bj = 0; bj < 2; ++bj) {
                        const int hd = u.pn * 2 + bj;
                        *(u32x4*)(qrow + hd * 192 + colb) = pack8(acc[ai][bj][m][0] * rstd, acc[ai][bj][m][1] * rstd);
                    }
                } else {
                    const int hd = (u.pn - 4) * 4 + wc; const int j0 = 8 * fq;
                    const f32x4* tp = (const f32x4*)(J.f1 + ((size_t)row * 32 + j0) * 2);
                    const f32x4 t0 = tp[0], t1 = tp[1], t2 = tp[2], t3 = tp[3];
                    const f32x4 a0 = acc[ai][0][m][0] * rstd, a1 = acc[ai][0][m][1] * rstd, b0 = acc[ai][1][m][0] * rstd, b1 = acc[ai][1][m][1] * rstd;
                    f32x4 o0, o1, p0, p1;
                    o0[0] = a0[0] * t0[0] - b0[0] * t0[1]; p0[0] = a0[0] * t0[1] + b0[0] * t0[0];
                    o0[1] = a0[1] * t0[2] - b0[1] * t0[3]; p0[1] = a0[1] * t0[3] + b0[1] * t0[2];
                    o0[2] = a0[2] * t1[0] - b0[2] * t1[1]; p0[2] = a0[2] * t1[1] + b0[2] * t1[0];
                    o0[3] = a0[3] * t1[2] - b0[3] * t1[3]; p0[3] = a0[3] * t1[3] + b0[3] * t1[2];
                    o1[0] = a1[0] * t2[0] - b1[0] * t2[1]; p1[0] = a1[0] * t2[1] + b1[0] * t2[0];
                    o1[1] = a1[1] * t2[2] - b1[1] * t2[3]; p1[1] = a1[1] * t2[3] + b1[1] * t2[2];
                    o1[2] = a1[2] * t3[0] - b1[2] * t3[1]; p1[2] = a1[2] * t3[1] + b1[2] * t3[0];
                    o1[3] = a1[3] * t3[2] - b1[3] * t3[3]; p1[3] = a1[3] * t3[3] + b1[3] * t3[2];
                    *(u32x4*)(qrow + hd * 192 + 128 + j0) = pack8(o0, o1); *(u32x4*)(qrow + hd * 192 + 160 + j0) = pack8(p0, p1);
                }
                EPI_FENCE();
            }
    } break;
    case EPI_UKV: { if (!((EPI_MASK >> EPI_UKV) & 1)) break;
        J.out = (bf16_t*)(ws + WS_R1) + (size_t)T_TOK * 1536; J.out2 = (bf16_t*)(ws + WS_R1) + (size_t)2 * T_TOK * 1536; J.f0 = (const float*)(ws + WS_SSQKV); J.f1 = (const float*)(ws + WS_R3 + 64 * MiB); J.b0 = (bf16_t*)(ws + WS_R3);
        const int hd = u.pn;
#pragma unroll
        for (int ai = 0; ai < 2; ++ai)
#pragma unroll
            for (int m = 0; m < 4; ++m) {
                const int row = rowb + ai * HALF + m * 16;
                const float rstd = 1.0f / sqrtf(J.f0[row] * (1.0f / 256.0f) + 1e-6f);
                bf16_t* krow = J.out + (size_t)row * 1536 + hd * 192;
                *(u32x4*)(krow + colb) = pack8(acc[ai][0][m][0] * rstd, acc[ai][0][m][1] * rstd);
                *(u32x4*)(J.out2 + (size_t)row * 1024 + hd * 128 + colb) = pack8(acc[ai][1][m][0] * rstd, acc[ai][1][m][1] * rstd);
                const int j = wc * 8 + fq * 2;
                const unsigned c1 = *(const unsigned*)(J.b0 + (size_t)row * 768 + 640 + j), c2 = *(const unsigned*)(J.b0 + (size_t)row * 768 + 672 + j);
                const f32x4 t = *(const f32x4*)(J.f1 + ((size_t)row * 32 + j) * 2);
                const float x0 = bf2f(c1 & 0xffffu), x1 = bf2f(c1 >> 16), y0 = bf2f(c2 & 0xffffu), y1 = bf2f(c2 >> 16);
                *(unsigned*)(krow + 128 + j) = cvt_pk_bf16(x0 * t[0] - y0 * t[1], x1 * t[2] - y1 * t[3]);
                *(unsigned*)(krow + 160 + j) = cvt_pk_bf16(x0 * t[1] + y0 * t[0], x1 * t[3] + y1 * t[2]);
                EPI_FENCE();
            }
    } break;
    default: break;
    }
}

__device__ __forceinline__ void gemm_phase(LAS unsigned char* lds, const GemmJob& g, const Sched& S, ArgsP ap, const int tid_in) {
    int tid = threadIdx.x; asm volatile("" : "+v"(tid)); (void)tid_in;
    const int wid = __builtin_amdgcn_readfirstlane(tid >> 6), lane = tid & 63, wr = wid >> 2, wc = wid & 3, fr = lane & 15, fq = lane >> 4;
    const int nt = g.K / BK;
    unsigned voffA[2], voffB[2];
#pragma unroll
    for (int i = 0; i < 2; ++i) { int R, C; stage_rc(tid * 16 + i * 8192, R, C); const int Rb = (R & ~31) + perm32(R & 31);
        voffA[i] = (unsigned)(R * g.lda + C) * 2u; voffB[i] = (unsigned)(Rb * g.ldb + C) * 2u; }
    const size_t kstep = (size_t)(BK * 2);
    const size_t hstepA = (size_t)HALF * g.lda * 2, hstepB = (size_t)HALF * g.ldb * 2;
    const unsigned ldsw = (unsigned)wid * 1024u;
    const int aoff = lds_byte(wr * 64 + fr, fq * 8), boff = lds_byte(wc * 32 + fr, fq * 8);
#define PG8_SA(b, h) (((b) * 2 + (h)) * HTB)
#define PG8_SB(b, h) ((4 + (b) * 2 + (h)) * HTB)
#define PG8_STAGE(bufoff, gbase, voff) do { _Pragma("unroll") for (int _i = 0; _i < 2; ++_i) \
        __builtin_amdgcn_global_load_lds((const unsigned*)((const char*)(gbase) + (voff)[_i]), (LAS unsigned*)(lds + (bufoff) + ldsw + _i * 8192), 16, 0, 0); } while (0)
#define PG8_LDA(dst, b, h) do { _Pragma("unroll") for (int m = 0; m < 4; ++m) _Pragma("unroll") for (int k = 0; k < 2; ++k) dst[m][k] = *(const LAS bf16x8*)(lds + PG8_SA(b, h) + aoff + m * 2048 + k * 1024); } while (0)
#define PG8_LDB(dst, b, h) do { _Pragma("unroll") for (int n = 0; n < 2; ++n) _Pragma("unroll") for (int k = 0; k < 2; ++k) dst[n][k] = *(const LAS bf16x8*)(lds + PG8_SB(b, h) + boff + n * 2048 + k * 1024); } while (0)
#define PG8_MMA(ai, bj, At, Bt) do { __builtin_amdgcn_s_setprio(1); _Pragma("unroll") for (int m = 0; m < 4; ++m) _Pragma("unroll") for (int n = 0; n < 2; ++n) _Pragma("unroll") for (int k = 0; k < 2; ++k) \
        acc[ai][bj][m][n] = __builtin_amdgcn_mfma_f32_16x16x32_bf16(Bt[n][k], At[m][k], acc[ai][bj][m][n], 0, 0, 0); __builtin_amdgcn_s_setprio(0); } while (0)
#define PG8_WAIT_V(n) asm volatile("s_waitcnt vmcnt(" #n ")" ::: "memory")
#define PG8_WAIT_L(n) asm volatile("s_waitcnt lgkmcnt(" #n ")" ::: "memory")
#define PG8_BAR __builtin_amdgcn_s_barrier()
#define PG8_SCHED __builtin_amdgcn_sched_barrier(0)
#define PG8_PTRA(u) ((const char*)g.A + 2 * ((size_t)((u).z / g.zdiv) * g.zAh + (size_t)((u).z % g.zdiv) * g.zAl + (size_t)(u).pm * BM * g.lda))
#define PG8_PTRB(u) ((const char*)g.Bt + 2 * ((size_t)((u).z / g.zdiv) * g.zBh + (size_t)((u).z % g.zdiv) * g.zBl + (size_t)(u).pn * BM * g.ldb))
    Unit cur, nxt; int ui = 0;
    if (!S.next(0, cur)) return;
    Acc acc;
#pragma unroll
    for (int a = 0; a < 2; ++a)
#pragma unroll
        for (int b = 0; b < 2; ++b)
#pragma unroll
            for (int m = 0; m < 4; ++m)
#pragma unroll
                for (int n = 0; n < 2; ++n) acc[a][b][m][n] = (f32x4){0.f, 0.f, 0.f, 0.f};
    bf16x8 At[4][2], B0[2][2], B1[2][2];
    const char* cA = PG8_PTRA(cur); const char* cB = PG8_PTRB(cur);
    PG8_STAGE(PG8_SB(0, 0), cB, voffB); PG8_STAGE(PG8_SB(0, 1), cB + hstepB, voffB); PG8_STAGE(PG8_SA(0, 0), cA, voffA); PG8_STAGE(PG8_SA(0, 1), cA + hstepA, voffA);
    if (wr == 1) PG8_BAR;
    PG8_WAIT_V(2); PG8_BAR;
    PG8_STAGE(PG8_SB(1, 0), cB + kstep, voffB); PG8_STAGE(PG8_SA(1, 0), cA + kstep, voffA); PG8_STAGE(PG8_SB(1, 1), cB + hstepB + kstep, voffB);
    PG8_WAIT_V(6); PG8_BAR;
    for (;;) {
        const bool has_next = S.next(ui + 1, nxt);
        const char* nA = cA; const char* nB = cB;
        if (has_next) { nA = PG8_PTRA(nxt); nB = PG8_PTRB(nxt); }
        for (int t = 0; t < nt; t += 2) {
            const bool last = (t == nt - 2);
            const char* a1 = cA + (size_t)(t + 1) * kstep;
            const char* a2 = last ? nA : cA + (size_t)(t + 2) * kstep; const char* b2 = last ? nB : cB + (size_t)(t + 2) * kstep;
            const char* a3 = a2 + kstep; const char* b3 = b2 + kstep;
            PG8_LDB(B0, 0, 0); PG8_LDB(B1, 0, 1); PG8_SCHED; PG8_LDA(At, 0, 0); PG8_STAGE(PG8_SA(1, 1), a1 + hstepA, voffA);
            PG8_WAIT_V(8); PG8_WAIT_L(0); PG8_BAR; PG8_MMA(0, 0, At, B0); PG8_MMA(0, 1, At, B1); PG8_BAR; PG8_SCHED;
            PG8_LDA(At, 0, 1); PG8_STAGE(PG8_SB(0, 0), b2, voffB); PG8_STAGE(PG8_SB(0, 1), b2 + hstepB, voffB); PG8_STAGE(PG8_SA(0, 0), a2, voffA);
            PG8_WAIT_V(8); PG8_WAIT_L(0); PG8_BAR; PG8_MMA(1, 0, At, B0); PG8_MMA(1, 1, At, B1); PG8_BAR; PG8_SCHED;
            PG8_LDB(B0, 1, 0); PG8_LDB(B1, 1, 1); PG8_SCHED; PG8_LDA(At, 1, 0); PG8_STAGE(PG8_SA(0, 1), a2 + hstepA, voffA);
            PG8_WAIT_V(8); PG8_WAIT_L(0); PG8_BAR; PG8_MMA(0, 0, At, B0); PG8_MMA(0, 1, At, B1); PG8_BAR; PG8_SCHED;
            PG8_LDA(At, 1, 1); PG8_STAGE(PG8_SB(1, 0), b3, voffB); PG8_STAGE(PG8_SB(1, 1), b3 + hstepB, voffB); PG8_STAGE(PG8_SA(1, 0), a3, voffA);
            PG8_WAIT_V(8); PG8_WAIT_L(0); PG8_BAR; PG8_MMA(1, 0, At, B0); PG8_MMA(1, 1, At, B1); PG8_BAR; PG8_SCHED;
        }
        if (wr == 0) PG8_BAR;
        epilogue(acc, cur, wr, wc, fr, fq, g.epi, g.var, ap);
        if (!has_next) break;
#pragma unroll
        for (int a = 0; a < 2; ++a)
#pragma unroll
            for (int b = 0; b < 2; ++b)
#pragma unroll
                for (int m = 0; m < 4; ++m)
#pragma unroll
                    for (int n = 0; n < 2; ++n) acc[a][b][m][n] = (f32x4){0.f, 0.f, 0.f, 0.f};
        cur = nxt; cA = nA; cB = nB; ++ui;
        if (wr == 1) PG8_BAR;
    }
    PG8_WAIT_V(0);
    PG8_BAR;
#undef PG8_SA
#undef PG8_SB
#undef PG8_STAGE
#undef PG8_LDA
#undef PG8_LDB
#undef PG8_MMA
#undef PG8_WAIT_V
#undef PG8_WAIT_L
#undef PG8_BAR
#undef PG8_SCHED
#undef PG8_PTRA
#undef PG8_PTRB
}

namespace mla {
constexpr int LDQ = 1536, LDK = 1536, LDV = 1024, LDO = 1024;
constexpr int KT_BYTES = 64 * 192 * 2, VT_BYTES = 64 * 128 * 2;
constexpr int V_OFF = 0, K_OFF = 2 * VT_BYTES, WS_OFF = K_OFF + 2 * KT_BYTES;
constexpr float SCALE = 0.07216878364870322f;
constexpr float THR = 8.f;
#define KSWZ(row, colB) ((row) * 384 + ((colB) ^ (((row) & 7) << 4)))
#define SBAR() __builtin_amdgcn_sched_barrier(0)
__device__ __forceinline__ int crow(int r, int hi) { return (r & 3) + 8 * (r >> 2) + 4 * hi; }
__device__ __forceinline__ void partialSM(f32x16& p0, f32x16& p1, float& m_reg, float& mn, float& alpha) {
    constexpr float C = SCALE * 1.4426950408889634f;
    float pmax = p0[0];
#pragma unroll
    for (int r = 1; r < 16; ++r) pmax = fmaxf(pmax, p0[r]);
#pragma unroll
    for (int r = 0; r < 16; ++r) pmax = fmaxf(pmax, p1[r]);
    { auto rr = __builtin_amdgcn_permlane32_swap(__float_as_uint(pmax), __float_as_uint(pmax), false, false);
      pmax = fmaxf(__uint_as_float(rr[0]), __uint_as_float(rr[1])); }
    if (__builtin_expect(__all(pmax - m_reg <= THR / SCALE), 1)) { mn = m_reg; alpha = 1.f; }
    else { mn = fmaxf(m_reg, pmax); alpha = __builtin_amdgcn_exp2f((m_reg - mn) * C); m_reg = mn; }
    const float mnC = -mn * C;
#pragma unroll
    for (int r = 0; r < 16; ++r) p0[r] = __builtin_amdgcn_exp2f(fmaf(p0[r], C, mnC));
#pragma unroll
    for (int r = 0; r < 16; ++r) p1[r] = __builtin_amdgcn_exp2f(fmaf(p1[r], C, mnC));
}
__device__ __forceinline__ void finishSM(f32x16& p0, f32x16& p1, float alpha, float& l_reg, bf16x8& pa0, bf16x8& pa1, bf16x8& pa2, bf16x8& pa3) {
    float ps = 0;
#pragma unroll
    for (int r = 0; r < 16; ++r) ps += p0[r];
#pragma unroll
    for (int r = 0; r < 16; ++r) ps += p1[r];
    { auto rr = __builtin_amdgcn_permlane32_swap(__float_as_uint(ps), __float_as_uint(ps), false, false);
      ps = __uint_as_float(rr[0]) + __uint_as_float(rr[1]); }
    l_reg = l_reg * alpha + ps;
#define PK4(P, BASE, OUT) do { unsigned a0 = cvt_pk_bf16(P[BASE + 0], P[BASE + 1]), a1 = cvt_pk_bf16(P[BASE + 2], P[BASE + 3]);   \
    unsigned b0 = cvt_pk_bf16(P[BASE + 4], P[BASE + 5]), b1 = cvt_pk_bf16(P[BASE + 6], P[BASE + 7]);                              \
    auto r0 = __builtin_amdgcn_permlane32_swap(a0, b0, false, false); auto r1 = __builtin_amdgcn_permlane32_swap(a1, b1, false, false); \
    u32x4 w = {r0[0], r1[0], r0[1], r1[1]}; OUT = *reinterpret_cast<bf16x8*>(&w); } while (0)
    PK4(p0, 0, pa0); PK4(p0, 8, pa1); PK4(p1, 0, pa2); PK4(p1, 8, pa3);
#undef PK4
}
__device__ __forceinline__ int v_st(int k, int c) { const int kk = (k & ~0xC) | ((k & 4) << 1) | ((k & 8) >> 1); return ((kk >> 3) * 4 + (c >> 5)) * 512 + ((kk & 7) * 32 + (c & 31)) * 2; }
__device__ __forceinline__ int v_rd_base(int lane) { return ((lane & 3) << 3) | (((lane >> 2) & 3) << 6) | (((lane >> 4) & 1) << 5) | (((lane >> 5) & 1) << 8); }
constexpr int v_rd_off(int d0, int ks, int half) { return d0 * 512 + ks * 4096 + half * 2048; }
template <int OFF> __device__ __forceinline__ s16x4 tr_read(int vb) {
    s16x4 r; asm volatile("ds_read_b64_tr_b16 %0, %1 offset:%2" : "=&v"(r) : "v"(vb), "i"(OFF) : "memory"); return r;
}
template <int D0> __device__ __forceinline__ void pv_one(f32x16& od, int vb, bf16x8 pa0, bf16x8 pa1, bf16x8 pa2, bf16x8 pa3) {
    const s16x4 l0 = tr_read<v_rd_off(D0, 0, 0)>(vb), h0 = tr_read<v_rd_off(D0, 0, 1)>(vb), l1 = tr_read<v_rd_off(D0, 1, 0)>(vb), h1 = tr_read<v_rd_off(D0, 1, 1)>(vb);
    const s16x4 l2 = tr_read<v_rd_off(D0, 2, 0)>(vb), h2 = tr_read<v_rd_off(D0, 2, 1)>(vb), l3 = tr_read<v_rd_off(D0, 3, 0)>(vb), h3 = tr_read<v_rd_off(D0, 3, 1)>(vb);
    asm volatile("s_waitcnt lgkmcnt(0)" ::: "memory"); SBAR();
#define PK(L, H) (bf16x8){L[0], L[1], L[2], L[3], H[0], H[1], H[2], H[3]}
    od = __builtin_amdgcn_mfma_f32_32x32x16_bf16(pa0, PK(l0, h0), od, 0, 0, 0);
    od = __builtin_amdgcn_mfma_f32_32x32x16_bf16(pa1, PK(l1, h1), od, 0, 0, 0);
    od = __builtin_amdgcn_mfma_f32_32x32x16_bf16(pa2, PK(l2, h2), od, 0, 0, 0);
    od = __builtin_amdgcn_mfma_f32_32x32x16_bf16(pa3, PK(l3, h3), od, 0, 0, 0);
#undef PK
}
__device__ __forceinline__ void attn_unit(const bf16_t* __restrict__ Qb, const bf16_t* __restrict__ Kh, const bf16_t* __restrict__ Vh, bf16_t* __restrict__ Ob, char* lds, const int tid_in) {
    int tid = threadIdx.x; asm volatile("" : "+v"(tid)); (void)tid_in;
    const int wid = tid >> 6, lane = tid & 63, r32 = lane & 31, hi = lane >> 5;
    char* V_lds = lds + V_OFF; char* K_lds = lds + K_OFF;
    float* ws = (float*)(lds + WS_OFF) + wid * 64; float* li_l = ws; float* al_l = ws + 32;
    float m_reg = -1e30f, l_reg = 0; f32x16 o0 = {}, o1 = {}, o2 = {}, o3 = {}; bf16x8 qr[12];
    const bf16_t* Qw = Qb + (size_t)(wid * 32 + r32) * LDQ + hi * 8;
#pragma unroll
    for (int d0 = 0; d0 < 12; ++d0) qr[d0] = *(const bf16x8*)(Qw + d0 * 16);
    LAS unsigned char* ldsl = (LAS unsigned char*)lds;
    unsigned kof[3], vof[2];
#pragma unroll
    for (int i = 0; i < 3; ++i) { const int p = (i * 8 + wid) * 64 + lane, row = p / 24, chs = p % 24, ch = (chs & ~7) | ((chs ^ row) & 7); kof[i] = (unsigned)(row * LDK + ch * 8) * 2u; }
#pragma unroll
    for (int i = 0; i < 2; ++i) { const int p = (i * 8 + wid) * 64 + lane, sub = p >> 5, kkh = sub >> 2, chh = sub & 3, kkl = (p & 31) >> 2, cl = (p & 3) * 8;
        const int kk = kkh * 8 + kkl, k = (kk & ~0xC) | ((kk & 4) << 1) | ((kk & 8) >> 1), c = chh * 32 + cl; vof[i] = (unsigned)(k * LDV + c) * 2u; }
    const int vb0 = (int)(uintptr_t)V_lds + v_rd_base(lane);
    const int wofs = __builtin_amdgcn_readfirstlane(wid) * 1024;
#define SDMA(k0, b) do { \
    _Pragma("unroll") for (int _i = 0; _i < 3; ++_i) __builtin_amdgcn_global_load_lds((const unsigned*)((const char*)Kh + (size_t)(k0) * LDK * 2 + kof[_i]), (LAS unsigned*)(ldsl + K_OFF + (b) * KT_BYTES + _i * 8192 + wofs), 16, 0, 0); \
    _Pragma("unroll") for (int _i = 0; _i < 2; ++_i) __builtin_amdgcn_global_load_lds((const unsigned*)((const char*)Vh + (size_t)(k0) * LDV * 2 + vof[_i]), (LAS unsigned*)(ldsl + V_OFF + (b) * VT_BYTES + _i * 8192 + wofs), 16, 0, 0); } while (0)
    constexpr int NT = SEQ / 64;
    SDMA(0, 0); asm volatile("s_waitcnt vmcnt(0)" ::: "memory"); __syncthreads();
    for (int j = 0; j < NT; ++j) {
        const int cur = j & 1;
        if (j + 1 < NT) SDMA((j + 1) * 64, cur ^ 1);
        f32x16 p0 = {}, p1 = {};
        const char* Ks = K_lds + cur * KT_BYTES;
#pragma unroll
        for (int d0 = 0; d0 < 12; ++d0) { const int cb = (d0 * 16 + hi * 8) * 2;
            const bf16x8 b0 = *(const bf16x8*)(Ks + KSWZ(r32, cb));
            const bf16x8 b1 = *(const bf16x8*)(Ks + KSWZ(32 + r32, cb));
            p0 = __builtin_amdgcn_mfma_f32_32x32x16_bf16(b0, qr[d0], p0, 0, 0, 0);
            p1 = __builtin_amdgcn_mfma_f32_32x32x16_bf16(b1, qr[d0], p1, 0, 0, 0); }
        float mn, alpha; bf16x8 pa0, pa1, pa2, pa3;
        partialSM(p0, p1, m_reg, mn, alpha);
        if (__any(alpha < 1.f)) { if (hi == 0) al_l[r32] = alpha; asm volatile("s_waitcnt lgkmcnt(0)" ::: "memory");
#pragma unroll
            for (int r = 0; r < 16; ++r) { const float a = al_l[crow(r, hi)]; o0[r] *= a; o1[r] *= a; o2[r] *= a; o3[r] *= a; } }
        finishSM(p0, p1, alpha, l_reg, pa0, pa1, pa2, pa3);
        const int vb = vb0 + cur * VT_BYTES;
        pv_one<0>(o0, vb, pa0, pa1, pa2, pa3); pv_one<1>(o1, vb, pa0, pa1, pa2, pa3); pv_one<2>(o2, vb, pa0, pa1, pa2, pa3); pv_one<3>(o3, vb, pa0, pa1, pa2, pa3);
        asm volatile("s_waitcnt vmcnt(0)" ::: "memory");
        __syncthreads();
    }
    if (hi == 0) li_l[r32] = l_reg; asm volatile("s_waitcnt lgkmcnt(0)" ::: "memory");
    bf16_t* Ow = Ob + (size_t)(wid * 32) * LDO;
#pragma unroll
    for (int r = 0; r < 16; ++r) { const int orow = crow(r, hi); const float rl = __builtin_amdgcn_rcpf(li_l[orow]);
        bf16_t* op = Ow + (size_t)orow * LDO + r32;
        op[0] = (bf16_t)(cvt_pk_bf16(o0[r] * rl, 0.f) & 0xffffu); op[32] = (bf16_t)(cvt_pk_bf16(o1[r] * rl, 0.f) & 0xffffu);
        op[64] = (bf16_t)(cvt_pk_bf16(o2[r] * rl, 0.f) & 0xffffu); op[96] = (bf16_t)(cvt_pk_bf16(o3[r] * rl, 0.f) & 0xffffu); }
    __syncthreads();
#undef SDMA
}
}


__device__ __forceinline__ void tr_item(const float* W, int K, int Nsrc, bf16_t* WT, int nrow0, int srccol0, bool zero, const float* kscale, int k0, LAS float* scr, int lane) {
#pragma unroll 8
    for (int i = 0; i < 32; ++i) { const int kk = 2 * i + (lane >> 5);
        float v = 0.f; if (!zero) { v = W[(size_t)(k0 + kk) * Nsrc + srccol0 + (lane & 31)]; if (kscale) v *= kscale[k0 + kk]; }
        scr[kk * 33 + (lane & 31)] = v; }
    asm volatile("s_waitcnt lgkmcnt(0)" ::: "memory");
    const int c = lane & 7;
#pragma unroll
    for (int j = 0; j < 4; ++j) { const int n = (lane >> 3) + 8 * j; const LAS float* s = scr + (8 * c) * 33 + n;
        u32x4 o; o.x = cvt_pk_bf16(s[0 * 33], s[1 * 33]); o.y = cvt_pk_bf16(s[2 * 33], s[3 * 33]); o.z = cvt_pk_bf16(s[4 * 33], s[5 * 33]); o.w = cvt_pk_bf16(s[6 * 33], s[7 * 33]);
        *(u32x4*)(WT + (size_t)(nrow0 + n) * K + k0 + 8 * c) = o; }
    asm volatile("s_waitcnt lgkmcnt(0)" ::: "memory");
}
__device__ __forceinline__ void tr_matrix_item(int id, int item, ArgsP a, LAS float* scr, int lane) {
    const float* W; int K, Nsrc, Ndst; bf16_t* WT; const float* ksc = nullptr;
    unsigned char* ws = a->ws;
    switch (id) {
    case 0: W = a->in[6]; K = 1024; Nsrc = 6144; Ndst = 6144; WT = (bf16_t*)(ws + WS_RWIN); break;
    case 1: W = a->in[10]; K = 2048; Nsrc = 1024; Ndst = 1024; WT = (bf16_t*)(ws + WS_RWOUT); break;
    case 2: W = a->in[11]; K = 1024; Nsrc = 704; Ndst = 768; WT = (bf16_t*)(ws + WS_MWIN); break;
    case 3: W = a->in[13]; K = 384; Nsrc = 1536; Ndst = 1536; WT = (bf16_t*)(ws + WS_MWUQ); ksc = a->in[12]; break;
    case 4: W = a->in[15]; K = 256; Nsrc = 2048; Ndst = 2048; WT = (bf16_t*)(ws + WS_MWUKV); ksc = a->in[14]; break;
    case 5: W = a->in[16]; K = 1024; Nsrc = 1024; Ndst = 1024; WT = (bf16_t*)(ws + WS_MWOUT); break;
    case 6: W = a->in[17]; K = 1024; Nsrc = 4096; Ndst = 4096; WT = (bf16_t*)(ws + WS_W1); break;
    case 7: W = a->in[17] + (size_t)1024 * 4096; K = 1024; Nsrc = 4096; Ndst = 4096; WT = (bf16_t*)(ws + WS_W1) + (size_t)4096 * 1024; break;
    case 8: W = a->in[18]; K = 4096; Nsrc = 1024; Ndst = 1024; WT = (bf16_t*)(ws + WS_W2); break;
    default: W = a->in[18] + (size_t)4096 * 1024; K = 4096; Nsrc = 1024; Ndst = 1024; WT = (bf16_t*)(ws + WS_W2) + (size_t)1024 * 4096; break;
    }
    const int nblk = Ndst / 32, kb = item / nblk, nb = item % nblk, n0 = nb * 32;
    int src0 = n0; bool zero = false;
    if (id == 2) zero = (n0 >= 704);
    if (id == 3) {
        if (n0 < 1024) { src0 = (n0 >> 7) * 192 + (n0 & 127); }
        else { const int r = n0 - 1024, t = r >> 8, cc = r & 255, half = cc >> 7, hh = (cc & 127) >> 5; src0 = (4 * t + hh) * 192 + 128 + half * 32; }
    }
    tr_item(W, K, Nsrc, WT, n0, src0, zero, ksc, kb * 64, scr, lane);
}
__device__ __forceinline__ void prep_phase(ArgsP a, char* lds_g, int G, const int tid_in) {
    LAS unsigned char* lds = (LAS unsigned char*)lds_g;
    int tid = threadIdx.x; asm volatile("" : "+v"(tid)); (void)tid_in;
    const int lane = tid & 63, wave = tid >> 6;
    unsigned char* ws = a->ws;
    {
        LAS float* scr = (LAS float*)(lds + wave * 16384);
        const int gw = blockIdx.x * 8 + wave, NGW = G * 8;
        constexpr int C0 = 16 * 192, C1 = C0 + 32 * 32, C2 = C1 + 16 * 24, C3 = C2 + 6 * 48, C4 = C3 + 4 * 64, C5 = C4 + 16 * 32, C6 = C5 + 16 * 128, C7 = C6 + 16 * 128, C8 = C7 + 64 * 32, C9 = C8 + 64 * 32;
        for (int it = gw; it < C9; it += NGW) {
            int r, id;
            if (it < C0) { id = 0; r = it; } else if (it < C1) { id = 1; r = it - C0; } else if (it < C2) { id = 2; r = it - C1; } else if (it < C3) { id = 3; r = it - C2; }
            else if (it < C4) { id = 4; r = it - C3; } else if (it < C5) { id = 5; r = it - C4; } else if (it < C6) { id = 6; r = it - C5; } else if (it < C7) { id = 7; r = it - C6; }
            else if (it < C8) { id = 8; r = it - C7; } else { id = 9; r = it - C8; }
            tr_matrix_item(id, r, a, scr, lane);
        }
    }
    __syncthreads();
    {
        LAS float* cact = (LAS float*)lds; LAS float* red = (LAS float*)(lds + 65536);
        const float* c = a->in[1];
        for (int i = tid; i < 16384; i += 512) { const float v = c[i]; cact[i] = v / (1.0f + __expf(-v)); }
        __syncthreads();
        float* mod = (float*)(ws + WS_MOD);
        for (int u = blockIdx.x; u < 192; u += G) {
            const int l = u / 96, cgp = u % 96, col = cgp * 64 + lane;
            float accv[16];
#pragma unroll
            for (int b = 0; b < 16; ++b) accv[b] = 0.f;
            const float* w = a->in[4] + (size_t)l * 1024 * 6144 + col;
#pragma unroll 4
            for (int k = wave * 128; k < wave * 128 + 128; ++k) { const float wv = w[(size_t)k * 6144];
#pragma unroll
                for (int b = 0; b < 16; ++b) accv[b] = fmaf(cact[b * 1024 + k], wv, accv[b]); }
#pragma unroll
            for (int b = 0; b < 16; ++b) red[(wave * 16 + b) * 64 + lane] = accv[b];
            __syncthreads();
            for (int o = tid; o < 1024; o += 512) { const int b = o >> 6, cc = o & 63; float s = 0.f;
#pragma unroll
                for (int kg = 0; kg < 8; ++kg) s += red[(kg * 16 + b) * 64 + cc];
                mod[(size_t)(l * 16 + b) * 6144 + cgp * 64 + cc] = s + a->in[5][l * 6144 + cgp * 64 + cc]; }
            __syncthreads();
        }
    }
    {
        const size_t gt = (size_t)blockIdx.x * 512 + tid, NT_ = (size_t)G * 512;
        const int* pos = (const int*)a->in[2];
        f32x2* tab = (f32x2*)(ws + WS_R3);
        for (size_t idx = gt; idx < (size_t)T_TOK * 128; idx += NT_) { const int t = (int)(idx >> 7), j = (int)(idx & 127);
            const float ang = (float)pos[t] * INVF_RET[j]; float s, c; sincos_f(ang, s, c);
            tab[idx] = (f32x2){c, s}; }
        float* z1 = (float*)(ws + WS_SSQQ); float* z2 = (float*)(ws + WS_SSQKV); float* z3 = (float*)(ws + WS_GN);
        for (size_t idx = gt; idx < (size_t)T_TOK; idx += NT_) { z1[idx] = 0.f; z2[idx] = 0.f; }
        for (size_t idx = gt; idx < (size_t)T_TOK * 8; idx += NT_) z3[idx] = 0.f;
        if (gt < 8) { const float x = (gt < 4) ? a->in[7][gt] : a->in[8][gt - 4]; ((float*)(ws + WS_DEC))[gt] = -log1pf(expf(-x)) * 1.4426950408889634f; }
    }
}

struct RowJob { const float* xin; const bf16_t* y; const float* wpost; const float* gate; float* xout; const float* wpre; const float* sc; const float* sh; bf16_t* hdn; int mla_tab; };
__device__ __forceinline__ void row_phase(const RowJob& R, ArgsP a, int G, const int tid_in) {
    int tid = threadIdx.x; asm volatile("" : "+v"(tid)); (void)tid_in;
    const int lane = tid & 63, wave = tid >> 6;
    const int gw = blockIdx.x * 8 + wave, NGW = G * 8;
    for (int row = gw; row < T_TOK; row += NGW) {
        const int b = row >> 11;
        const f32x4* xr = (const f32x4*)(R.xin + (size_t)row * DM) + lane;
        f32x4 v[4];
#pragma unroll
        for (int j = 0; j < 4; ++j) v[j] = xr[64 * j];
        if (R.y) {
            const u32x2* yr = (const u32x2*)(R.y + (size_t)row * DM) + lane;
            f32x4 y[4]; float s = 0.f;
#pragma unroll
            for (int j = 0; j < 4; ++j) { const u32x2 w = yr[64 * j]; y[j][0] = bf2f(w.x & 0xffffu); y[j][1] = bf2f(w.x >> 16); y[j][2] = bf2f(w.y & 0xffffu); y[j][3] = bf2f(w.y >> 16);
                s += (y[j][0] * y[j][0] + y[j][1] * y[j][1]) + (y[j][2] * y[j][2] + y[j][3] * y[j][3]); }
            const float rstd = 1.0f / sqrtf(wave_sum(s) * (1.0f / DM) + 1e-6f);
            const f32x4* wp = (const f32x4*)R.wpost + lane; const f32x4* gp = (const f32x4*)(R.gate + (size_t)b * 6144) + lane;
            f32x4* xo = (f32x4*)(R.xout + (size_t)row * DM) + lane;
#pragma unroll
            for (int j = 0; j < 4; ++j) { const f32x4 w = wp[64 * j], g = gp[64 * j]; v[j] = v[j] + g * ((y[j] * rstd) * w); xo[64 * j] = v[j]; }
        }
        if (R.hdn) {
            float s = 0.f;
#pragma unroll
            for (int j = 0; j < 4; ++j) s += (v[j][0] * v[j][0] + v[j][1] * v[j][1]) + (v[j][2] * v[j][2] + v[j][3] * v[j][3]);
            const float rstd = 1.0f / sqrtf(wave_sum(s) * (1.0f / DM) + 1e-6f);
            const f32x4* wp = (const f32x4*)R.wpre + lane; const f32x4* scp = (const f32x4*)(R.sc + (size_t)b * 6144) + lane; const f32x4* shp = (const f32x4*)(R.sh + (size_t)b * 6144) + lane;
            u32x2* ho = (u32x2*)(R.hdn + (size_t)row * DM) + lane;
#pragma unroll
            for (int j = 0; j < 4; ++j) { const f32x4 w = wp[64 * j], sc = scp[64 * j], sh = shp[64 * j];
                const f32x4 h = ((v[j] * rstd) * w) * (1.0f + sc) + sh; u32x2 o; o.x = cvt_pk_bf16(h[0], h[1]); o.y = cvt_pk_bf16(h[2], h[3]); ho[64 * j] = o; }
        }
    }
    if (R.mla_tab) {
        const size_t gt = (size_t)blockIdx.x * 512 + tid, NT_ = (size_t)G * 512;
        const int* pos = (const int*)a->in[2];
        f32x2* tab = (f32x2*)(a->ws + WS_R3 + 64 * MiB);
        for (size_t idx = gt; idx < (size_t)T_TOK * 32; idx += NT_) { const int t = (int)(idx >> 5), j = (int)(idx & 31);
            const float ang = (float)pos[t] * INVF_MLA[j]; float s, c; sincos_f(ang, s, c);
            tab[idx] = (f32x2){c, s}; }
    }
}

constexpr int NJOBS = 27;
enum { K_PREP = 0, K_ROW = 1, K_GEMM = 2, K_ATTN = 3 };
__host__ __device__ __forceinline__ int job_sync_after(int j) { return !(j == 2 || j == 19 || j == 26); }

__device__ __forceinline__ RowJob make_row(int j, ArgsP ap) {
    unsigned char* ws = ap->ws; const float* mod = (const float*)(ws + WS_MOD); const float* normw = ap->in[3]; float* out = ap->out;
    bf16_t* HDN = (bf16_t*)(ws + WS_HDN); const bf16_t* R1 = (const bf16_t*)(ws + WS_R1); const bf16_t* R3 = (const bf16_t*)(ws + WS_R3);
    RowJob r{};
    if (j == 1) { r.xin = ap->in[0]; r.y = nullptr; r.wpre = normw + 0 * 1024; r.sc = mod + 1 * 1024; r.sh = mod + 0 * 1024; r.hdn = HDN; }
    else if (j == 14) { r.xin = ap->in[0]; r.y = R3; r.wpost = normw + 1 * 1024; r.gate = mod + 2 * 1024; r.xout = out; r.wpre = normw + 2 * 1024; r.sc = mod + 4 * 1024; r.sh = mod + 3 * 1024; r.hdn = HDN; }
    else if (j == 17) { r.xin = out; r.y = R3; r.wpost = normw + 3 * 1024; r.gate = mod + 5 * 1024; r.xout = out; r.wpre = normw + 4 * 1024; r.sc = mod + 16 * 6144 + 1 * 1024; r.sh = mod + 16 * 6144 + 0 * 1024; r.hdn = HDN; r.mla_tab = 1; }
    else if (j == 23) { r.xin = out; r.y = R1; r.wpost = normw + 5 * 1024; r.gate = mod + 16 * 6144 + 2 * 1024; r.xout = out; r.wpre = normw + 6 * 1024; r.sc = mod + 16 * 6144 + 4 * 1024; r.sh = mod + 16 * 6144 + 3 * 1024; r.hdn = HDN; }
    else { r.xin = out; r.y = R3; r.wpost = normw + 7 * 1024; r.gate = mod + 16 * 6144 + 5 * 1024; r.xout = out; r.hdn = nullptr; }
    return r;
}
__device__ __forceinline__ GemmJob make_gemm(int j, unsigned char* ws) {
    GemmJob g{}; g.zdiv = 1; g.nZ = 1;
    bf16_t* HDN = (bf16_t*)(ws + WS_HDN);
    bf16_t* R1 = (bf16_t*)(ws + WS_R1); bf16_t* R2 = (bf16_t*)(ws + WS_R2); bf16_t* R3 = (bf16_t*)(ws + WS_R3);
    if (j == 2) {
        g.A = HDN; g.lda = 1024; g.Bt = (const bf16_t*)(ws + WS_RWIN); g.ldb = 1024; g.K = 1024; g.nM = 128; g.nN = 8; g.epi = EPI_RETQK;
    } else if (j == 3) {
        g.A = (const bf16_t*)(ws + WS_RWIN) + (size_t)2048 * 1024; g.lda = 1024; g.Bt = HDN; g.ldb = 1024; g.K = 1024; g.nM = 8; g.nN = 128; g.epi = EPI_STORE; g.var = 0;
    } else if (j >= 4 && j <= 11) {
        const int grp = (j - 4) >> 1;
        if (((j - 4) & 1) == 0) {
            g.A = R1 + (size_t)grp * 4 * 2 * 2048 * 1024; g.lda = 1024; g.zdiv = 4; g.zAh = (long)2 * 2048 * 1024; g.zAl = 256;
            g.Bt = g.A + (size_t)2048 * 1024; g.ldb = 1024; g.zBh = g.zAh; g.zBl = 256;
            g.K = 256; g.nM = 8; g.nN = 8; g.nZ = 16; g.epi = EPI_SDECAY;
        } else {
            g.A = R3; g.lda = 2048; g.zdiv = 4; g.zAh = (long)4 * 2048 * 2048; g.zAl = (long)2048 * 2048;
            g.Bt = R2 + (size_t)grp * 4 * 2048; g.ldb = T_TOK; g.zBh = 2048; g.zBl = (long)512 * T_TOK;
            g.K = 2048; g.nM = 8; g.nN = 2; g.nZ = 16; g.epi = EPI_OY; g.var = grp * 4;
        }
    } else if (j == 12) {
        g.A = HDN; g.lda = 1024; g.Bt = (const bf16_t*)(ws + WS_RWIN) + (size_t)4096 * 1024; g.ldb = 1024; g.K = 1024; g.nM = 128; g.nN = 8; g.epi = EPI_GATE;
    } else if (j == 13) {
        g.A = R1; g.lda = 2048; g.Bt = (const bf16_t*)(ws + WS_RWOUT); g.ldb = 2048; g.K = 2048; g.nM = 128; g.nN = 4; g.epi = EPI_STORE; g.var = 1;
    } else if (j == 15 || j == 24) {
        const int l = (j == 24);
        g.A = HDN; g.lda = 1024; g.Bt = (const bf16_t*)(ws + WS_W1) + (size_t)l * 4096 * 1024; g.ldb = 1024; g.K = 1024; g.nM = 128; g.nN = 16; g.epi = EPI_RELU2; g.var = 3;
    } else if (j == 16 || j == 25) {
        const int l = (j == 25);
        g.A = R1; g.lda = 4096; g.Bt = (const bf16_t*)(ws + WS_W2) + (size_t)l * 1024 * 4096; g.ldb = 4096; g.K = 4096; g.nM = 128; g.nN = 4; g.epi = EPI_STORE; g.var = 1;
    } else if (j == 18) {
        g.A = HDN; g.lda = 1024; g.Bt = (const bf16_t*)(ws + WS_MWIN); g.ldb = 1024; g.K = 1024; g.nM = 128; g.nN = 3; g.epi = EPI_WIN;
    } else if (j == 19) {
        g.A = R3; g.lda = 768; g.Bt = (const bf16_t*)(ws + WS_MWUQ); g.ldb = 384; g.K = 384; g.nM = 128; g.nN = 6; g.epi = EPI_UQ;
    } else if (j == 20) {
        g.A = R3 + 384; g.lda = 768; g.Bt = (const bf16_t*)(ws + WS_MWUKV); g.ldb = 256; g.K = 256; g.nM = 128; g.nN = 8; g.epi = EPI_UKV;
    } else {
        g.A = (const bf16_t*)(ws + WS_R3 + 64 * MiB); g.lda = 1024; g.Bt = (const bf16_t*)(ws + WS_MWOUT); g.ldb = 1024; g.K = 1024; g.nM = 128; g.nN = 4; g.epi = EPI_STORE; g.var = 2;
    }
    return g;
}

__global__ void __launch_bounds__(512, 2) fwd_megakernel(Args a) {
    extern __shared__ __attribute__((aligned(16))) unsigned char lds_raw[];
    const int G = gridDim.x;
    const int j_lo = a.j_lo, j_hi = a.j_hi;
    for (int j = j_lo; j < j_hi; ++j) {
        const int tidl = 0;
        ArgsP ap = (ArgsP)__builtin_amdgcn_kernarg_segment_ptr(); asm volatile("" : "+s"(ap));
        int kind;
        if (j == 0) kind = K_PREP;
        else if (j == 1 || j == 14 || j == 17 || j == 23 || j == 26) kind = K_ROW;
        else if (j == 21) kind = K_ATTN;
        else kind = K_GEMM;
        switch (kind) {
#ifndef NO_PREP
        case K_PREP: prep_phase(ap, (char*)lds_raw, G, tidl); break;
#endif
#ifndef NO_ROW
        case K_ROW: { const RowJob r = make_row(j, ap); row_phase(r, ap, G, tidl); } break;
#endif
#ifndef NO_GEMM
        case K_GEMM: { const GemmJob g = make_gemm(j, ap->ws); Sched S; S.init(g.nZ, g.nM, g.nN, G, (int)blockIdx.x); gemm_phase((LAS unsigned char*)lds_raw, g, S, ap, tidl); } break;
#endif
#ifndef NO_ATTN
        case K_ATTN: {
            unsigned char* ws = ap->ws;
            const bf16_t* Q1 = (const bf16_t*)(ws + WS_R1); const bf16_t* K1 = Q1 + (size_t)T_TOK * 1536; const bf16_t* V1 = Q1 + (size_t)2 * T_TOK * 1536;
            bf16_t* O = (bf16_t*)(ws + WS_R3 + 64 * MiB);
            const int vcu = (G % 8 == 0) ? ((int)blockIdx.x % 8) * (G / 8) + (int)blockIdx.x / 8 : (int)blockIdx.x;
            for (int un = vcu; un < NB * 8 * 8; un += G) {
                const int bh = un >> 3, qb = un & 7, b = bh >> 3, h = bh & 7;
                mla::attn_unit(Q1 + ((size_t)(b * 2048 + qb * 256) * 1536 + h * 192), K1 + ((size_t)b * 2048 * 1536 + h * 192), V1 + ((size_t)b * 2048 * 1024 + h * 128),
                               O + ((size_t)(b * 2048 + qb * 256) * 1024 + h * 128), (char*)lds_raw, tidl);
            }
        } break;
#endif
        default: break;
        }
        if (job_sync_after(j) && j + 1 < j_hi) { __syncthreads(); cg::this_grid().sync(); }
        else __syncthreads();
    }
}

extern "C" void kernel_launch(void* const* d_in, const int* in_sizes, int n_in, void* d_out, int out_size, void* d_ws, size_t ws_size, hipStream_t stream) {
    static int grid = 0;
    if (grid == 0) {
        if (n_in != 19 || out_size != T_TOK * DM || ws_size < WS_END) { fprintf(stderr, "kernel_launch: unexpected shapes n_in %d out %d ws %zu (need %zu)\n", n_in, out_size, ws_size, (size_t)WS_END); grid = -1; return; }
        int dev = 0, cus = 0, per_cu = 0;
        hipGetDevice(&dev); hipDeviceGetAttribute(&cus, hipDeviceAttributeMultiprocessorCount, dev);
        if (hipFuncSetAttribute((const void*)fwd_megakernel, hipFuncAttributeMaxDynamicSharedMemorySize, LDS_BYTES) != hipSuccess) { fprintf(stderr, "kernel_launch: hipFuncSetAttribute failed\n"); grid = -1; return; }
        if (hipOccupancyMaxActiveBlocksPerMultiprocessor(&per_cu, (const void*)fwd_megakernel, 512, LDS_BYTES) != hipSuccess || per_cu < 1) { fprintf(stderr, "kernel_launch: occupancy query says %d\n", per_cu); per_cu = 1; }
        (void)hipGetLastError();
        grid = cus * 1;
        fprintf(stderr, "kernel_launch: grid %d (cus %d, per_cu %d)\n", grid, cus, per_cu);
    }
    if (grid < 0) return;
    Args a{};
    for (int i = 0; i < 19; ++i) a.in[i] = (const float*)d_in[i];
    a.out = (float*)d_out; a.ws = (unsigned char*)d_ws;
#if MULTI_LAUNCH
    int lo = 0;
    for (int j = 0; j < NJOBS; ++j) {
        if (job_sync_after(j) || j == NJOBS - 1) {
            a.j_lo = lo; a.j_hi = j + 1; lo = j + 1;
            hipLaunchKernelGGL(fwd_megakernel, dim3(grid), dim3(512), LDS_BYTES, stream, a);
        }
    }
#else
    a.j_lo = 0; a.j_hi = NJOBS;
    void* args[] = {&a};
    hipError_t e = hipLaunchCooperativeKernel((const void*)fwd_megakernel, dim3(grid), dim3(512), args, LDS_BYTES, stream);
    if (e != hipSuccess) fprintf(stderr, "cooperative launch failed: %s (grid %d)\n", hipGetErrorString(e), grid);
#endif
}
```

```cpp
#include <hip/hip_runtime.h>
#include <hip/hip_cooperative_groups.h>
#include <cstdio>
#include <cstdint>
namespace cg = cooperative_groups;

#ifndef PROBE
#define PROBE 0
#endif
#ifndef PROBE_MASK
#define PROBE_MASK 0x5c0000u
#endif
#ifndef MULTI_LAUNCH
#define MULTI_LAUNCH 0
#endif

#define LAS __attribute__((address_space(3)))
typedef unsigned short bf16_t;
typedef short bf16x8 __attribute__((ext_vector_type(8)));
typedef short s16x4 __attribute__((ext_vector_type(4)));
typedef float f32x4 __attribute__((ext_vector_type(4)));
typedef float f32x2 __attribute__((ext_vector_type(2)));
typedef float f32x16 __attribute__((ext_vector_type(16)));
typedef unsigned u32x4 __attribute__((ext_vector_type(4)));
typedef unsigned u32x2 __attribute__((ext_vector_type(2)));

constexpr int T_TOK = 32768, DM = 1024, NB = 16, SEQ = 2048;
constexpr size_t MiB = 1u << 20;
constexpr size_t WS_MOD = 0;
constexpr size_t WS_BAR = 768 * 1024;
constexpr size_t WS_SSQQ = 1 * MiB;
constexpr size_t WS_SSQKV = 1 * MiB + 256 * 1024;
constexpr size_t WS_DEC = 1 * MiB + 512 * 1024;
constexpr size_t WS_GN = 2 * MiB;
constexpr size_t WS_RWIN = 4 * MiB;
constexpr size_t WS_RWOUT = 16 * MiB;
constexpr size_t WS_MWIN = 20 * MiB;
constexpr size_t WS_MWUQ = 22 * MiB;
constexpr size_t WS_MWUKV = 24 * MiB;
constexpr size_t WS_MWOUT = 25 * MiB;
constexpr size_t WS_W1 = 28 * MiB;
constexpr size_t WS_W2 = 44 * MiB;
constexpr size_t WS_HDN = 60 * MiB;
constexpr size_t WS_R1 = 124 * MiB;
constexpr size_t WS_R2 = 252 * MiB;
constexpr size_t WS_R3 = 380 * MiB;
constexpr size_t WS_END = 508 * MiB;

constexpr int LDS_BYTES = 132096;

struct Args { const float* in[19]; float* out; unsigned char* ws; int j_lo, j_hi; };
typedef const __attribute__((address_space(4))) Args* ArgsP;

__device__ __forceinline__ unsigned cvt_pk_bf16(float lo, float hi) { unsigned r; asm volatile("v_cvt_pk_bf16_f32 %0, %1, %2" : "=v"(r) : "v"(lo), "v"(hi)); return r; }
__device__ __forceinline__ float bf2f(unsigned h) { return __uint_as_float(h << 16); }
__device__ __forceinline__ u32x4 pack8(f32x4 a, f32x4 b) { u32x4 w; w.x = cvt_pk_bf16(a[0], a[1]); w.y = cvt_pk_bf16(a[2], a[3]); w.z = cvt_pk_bf16(b[0], b[1]); w.w = cvt_pk_bf16(b[2], b[3]); return w; }
__device__ __forceinline__ float wave_sum(float v) {
#pragma unroll
    for (int o = 1; o < 64; o <<= 1) v += __shfl_xor(v, o);
    return v;
}
__device__ const float INVF_RET[128] = {1.000000000e+00f, 9.305720329e-01f, 8.659643531e-01f, 8.058421612e-01f, 7.498942018e-01f, 6.978305578e-01f, 6.493816376e-01f, 6.042963862e-01f, 5.623413324e-01f, 5.232990980e-01f, 4.869675338e-01f, 4.531583786e-01f, 4.216965139e-01f, 3.924189806e-01f, 3.651741147e-01f, 3.398208320e-01f, 3.162277639e-01f, 2.942727208e-01f, 2.738419771e-01f, 2.548296750e-01f, 2.371373773e-01f, 2.206734121e-01f, 2.053525001e-01f, 1.910952926e-01f, 1.778279394e-01f, 1.654817164e-01f, 1.539926529e-01f, 1.433012635e-01f, 1.333521456e-01f, 1.240937784e-01f, 1.154781953e-01f, 1.074607819e-01f, 1.000000015e-01f, 9.305720776e-02f, 8.659642935e-02f, 8.058422059e-02f, 7.498942316e-02f, 6.978306174e-02f, 6.493816525e-02f, 6.042964011e-02f, 5.623413250e-02f, 5.232991278e-02f, 4.869675264e-02f, 4.531583562e-02f, 4.216964915e-02f, 3.924189880e-02f, 3.651741147e-02f, 3.398208320e-02f, 3.162277490e-02f, 2.942727134e-02f, 2.738419548e-02f, 2.548296750e-02f, 2.371373773e-02f, 2.206734009e-02f, 2.053525113e-02f, 1.910953037e-02f, 1.778279431e-02f, 1.654817164e-02f, 1.539926510e-02f, 1.433012541e-02f, 1.333521400e-02f, 1.240937784e-02f, 1.154781971e-02f, 1.074607857e-02f, 9.999999776e-03f, 9.305720218e-03f, 8.659643121e-03f, 8.058422245e-03f, 7.498942316e-03f, 6.978305988e-03f, 6.493816152e-03f, 6.042963825e-03f, 5.623413250e-03f, 5.232991185e-03f, 4.869675264e-03f, 4.531583749e-03f, 4.216964822e-03f, 3.924189601e-03f, 3.651741194e-03f, 3.398208413e-03f, 3.162277630e-03f, 2.942727180e-03f, 2.738419687e-03f, 2.548296703e-03f, 2.371373819e-03f, 2.206734149e-03f, 2.053525066e-03f, 1.910952968e-03f, 1.778279431e-03f, 1.654817141e-03f, 1.539926510e-03f, 1.433012541e-03f, 1.333521446e-03f, 1.240937738e-03f, 1.154782018e-03f, 1.074607833e-03f, 1.000000047e-03f, 9.305720450e-04f, 8.659643354e-04f, 8.058421663e-04f, 7.498941850e-04f, 6.978305755e-04f, 6.493816036e-04f, 6.042963942e-04f, 5.623413017e-04f, 5.232990952e-04f, 4.869675322e-04f, 4.531583691e-04f, 4.216965172e-04f, 3.924189659e-04f, 3.651741135e-04f, 3.398208355e-04f, 3.162277571e-04f, 2.942727297e-04f, 2.738419571e-04f, 2.548296761e-04f, 2.371373703e-04f, 2.206734061e-04f, 2.053525095e-04f, 1.910952997e-04f, 1.778279402e-04f, 1.654817170e-04f, 1.539926598e-04f, 1.433012512e-04f, 1.333521504e-04f, 1.240937709e-04f, 1.154782003e-04f, 1.074607862e-04f};
__device__ const float INVF_MLA[32] = {1.000000000e+00f, 7.498942018e-01f, 5.623413324e-01f, 4.216965139e-01f, 3.162277639e-01f, 2.371373773e-01f, 1.778279394e-01f, 1.333521456e-01f, 1.000000015e-01f, 7.498942316e-02f, 5.623413250e-02f, 4.216964915e-02f, 3.162277490e-02f, 2.371373773e-02f, 1.778279431e-02f, 1.333521400e-02f, 9.999999776e-03f, 7.498942316e-03f, 5.623413250e-03f, 4.216964822e-03f, 3.162277630e-03f, 2.371373819e-03f, 1.778279431e-03f, 1.333521446e-03f, 1.000000047e-03f, 7.498941850e-04f, 5.623413017e-04f, 4.216965172e-04f, 3.162277571e-04f, 2.371373703e-04f, 1.778279402e-04f, 1.333521504e-04f};
__device__ __forceinline__ void sincos_f(float x, float& s, float& c) {
    const float n = rintf(x * 0.636619772f);
    float r = fmaf(-n, 1.57079637050628662109375f, x); r = fmaf(-n, -4.37113900018624283e-8f, r); r = fmaf(-n, -1.7151245100059e-15f, r);
    const int q = ((int)n) & 3; const float r2 = r * r;
    const float sp = fmaf(fmaf(fmaf(-1.9515295891e-4f, r2, 8.3321608736e-3f), r2, -1.6666654611e-1f) * r2, r, r);
    const float cp = fmaf(fmaf(fmaf(2.443315711809948e-5f, r2, -1.388731625493765e-3f), r2, 4.166664568298827e-2f), r2 * r2, fmaf(-0.5f, r2, 1.0f));
    s = (q == 0) ? sp : (q == 1) ? cp : (q == 2) ? -sp : -cp;
    c = (q == 0) ? cp : (q == 1) ? -sp : (q == 2) ? -cp : sp;
}

constexpr int BM = 256, BK = 64, HALF = 128, HTB = HALF * BK * 2, NXCD = 8, WGM = 8;
__device__ __forceinline__ int lds_byte(int r, int c) { const int st = (r >> 4) * 2 + (c >> 5), rr = r & 15, cc = c & 31, ob = rr * 64 + cc * 2; return st * 1024 + (ob ^ (((ob >> 9) & 1) << 5)); }
__device__ __forceinline__ void stage_rc(int b, int& R, int& C) { const int st = b / 1024, sb = b % 1024, swz = sb ^ (((sb >> 9) & 1) << 5); R = (st >> 1) * 16 + swz / 64; C = (st & 1) * 32 + (swz % 64) / 2; }
__device__ __forceinline__ int perm32(int rho) { const int n = rho >> 4, i = rho & 15; return 8 * (i >> 2) + 4 * n + (i & 3); }

struct Unit { int z, pm, pn; };
enum { EPI_RETQK = 0, EPI_STORE = 1, EPI_RELU2 = 2, EPI_SDECAY = 3, EPI_OY = 4, EPI_GATE = 5, EPI_WIN = 6, EPI_UQ = 7, EPI_UKV = 8 };
struct GemmJob {
    const bf16_t* A; const bf16_t* Bt; int lda, ldb, K, nM, nN, nZ;
    long zAh, zAl, zBh, zBl; int zdiv;
    int epi; int var;
};
struct EpiPtr { bf16_t* out; bf16_t* out2; int ldc; long zC; const float* f0; const float* f1; float* s0; float* s1; const bf16_t* b0; };
struct Sched {
    int nM, nN, nwg, per, G, c;
    __device__ __forceinline__ void init(int nZ, int nM_, int nN_, int G_, int c_) { nM = nM_; nN = nN_; per = nM * nN; nwg = nZ * per; G = G_; c = c_; }
    __device__ __forceinline__ bool next(int i, Unit& u) const {
        const long L = (long)i * G + c; if (L >= nwg) return false;
        int wgid = (int)L; { const int q = nwg / NXCD, r = nwg % NXCD, xcd = wgid % NXCD, off = wgid / NXCD; wgid = (xcd < r ? xcd * (q + 1) : r * (q + 1) + (xcd - r) * q) + off; }
        u.z = wgid / per; const int w = wgid % per;
        const int nig = WGM * nN, gid = w / nig, fm = gid * WGM, gsz = (nM - fm) < WGM ? (nM - fm) : WGM;
        u.pm = fm + ((w % nig) % gsz); u.pn = (w % nig) / gsz; return true;
    }
};

typedef f32x4 Acc[2][2][4][2];

#ifndef EPI_MASK
#define EPI_MASK 0x1ff
#endif
#define EPI_FENCE() asm volatile("" ::: "memory")
__device__ __forceinline__ void epilogue(const Acc& acc, const Unit& u, int wr, int wc, int fr_in, int fq_in, const int epi, const int var, ArgsP ap) {
    unsigned char* ws = ap->ws;
    int fr = fr_in, fq = fq_in; asm volatile("" : "+v"(fr), "+v"(fq));
    const int rowb = u.pm * BM + wr * 64 + fr;
    const int colb = wc * 32 + 8 * fq;
    EpiPtr J{};
    switch (epi) {
    case EPI_RETQK: { if (!((EPI_MASK >> EPI_RETQK) & 1)) break;
        J.out = (bf16_t*)(ws + WS_R1); J.f0 = (const float*)(ws + WS_R3);
        const int kpart = u.pn >> 2, h = u.pn & 3; const float sc = kpart ? 0.0625f : 1.0f;
#pragma unroll
        for (int ai = 0; ai < 2; ++ai) {
            f32x4 tb[4][4];
#pragma unroll
            for (int m = 0; m < 4; ++m) {
                const int row = rowb + ai * HALF + m * 16;
                const f32x4* tp = (const f32x4*)(J.f0 + ((size_t)row * 128 + colb) * 2);
                tb[m][0] = tp[0]; tb[m][1] = tp[1]; tb[m][2] = tp[2]; tb[m][3] = tp[3];
            }
#pragma unroll
            for (int m = 0; m < 4; ++m) {
                const int row = rowb + ai * HALF + m * 16; const int b = row >> 11, s = row & 2047;
                bf16_t* dst = J.out + ((size_t)(b * 2 + kpart) * 2048 + s) * 1024 + h * 256 + colb;
                const f32x4 t0 = tb[m][0], t1 = tb[m][1], t2 = tb[m][2], t3 = tb[m][3];
                const f32x4 a0 = acc[ai][0][m][0], a1 = acc[ai][0][m][1], b0 = acc[ai][1][m][0], b1 = acc[ai][1][m][1];
                f32x4 o0, o1, p0, p1;
                o0[0] = (a0[0] * t0[0] - b0[0] * t0[1]) * sc; p0[0] = (a0[0] * t0[1] + b0[0] * t0[0]) * sc;
                o0[1] = (a0[1] * t0[2] - b0[1] * t0[3]) * sc; p0[1] = (a0[1] * t0[3] + b0[1] * t0[2]) * sc;
                o0[2] = (a0[2] * t1[0] - b0[2] * t1[1]) * sc; p0[2] = (a0[2] * t1[1] + b0[2] * t1[0]) * sc;
                o0[3] = (a0[3] * t1[2] - b0[3] * t1[3]) * sc; p0[3] = (a0[3] * t1[3] + b0[3] * t1[2]) * sc;
                o1[0] = (a1[0] * t2[0] - b1[0] * t2[1]) * sc; p1[0] = (a1[0] * t2[1] + b1[0] * t2[0]) * sc;
                o1[1] = (a1[1] * t2[2] - b1[1] * t2[3]) * sc; p1[1] = (a1[1] * t2[3] + b1[1] * t2[2]) * sc;
                o1[2] = (a1[2] * t3[0] - b1[2] * t3[1]) * sc; p1[2] = (a1[2] * t3[1] + b1[2] * t3[0]) * sc;
                o1[3] = (a1[3] * t3[2] - b1[3] * t3[3]) * sc; p1[3] = (a1[3] * t3[3] + b1[3] * t3[2]) * sc;
                *(u32x4*)dst = pack8(o0, o1); *(u32x4*)(dst + 128) = pack8(p0, p1);
            }
            EPI_FENCE();
        }
    } break;
    case EPI_STORE: case EPI_RELU2: { if (!((EPI_MASK >> EPI_STORE) & 1)) break;
        if (var == 0) { J.out = (bf16_t*)(ws + WS_R2); J.ldc = 2048; J.zC = (long)2048 * 2048; } else if (var == 1) { J.out = (bf16_t*)(ws + WS_R3); J.ldc = 1024; } else if (var == 2) { J.out = (bf16_t*)(ws + WS_R1); J.ldc = 1024; } else { J.out = (bf16_t*)(ws + WS_R1); J.ldc = 4096; }
        bf16_t* base = J.out + (size_t)(u.z & 15) * J.zC + u.pn * BM + colb;
#pragma unroll
        for (int ai = 0; ai < 2; ++ai)
#pragma unroll
            for (int m = 0; m < 4; ++m) {
                bf16_t* rowp = base + (size_t)(rowb + ai * HALF + m * 16) * J.ldc;
#pragma unroll
                for (int bj = 0; bj < 2; ++bj) {
                    f32x4 v0 = acc[ai][bj][m][0], v1 = acc[ai][bj][m][1];
                    if (epi == EPI_RELU2) {
#pragma unroll
                        for (int i = 0; i < 4; ++i) { const float x0 = fmaxf(v0[i], 0.f), x1 = fmaxf(v1[i], 0.f); v0[i] = x0 * x0; v1[i] = x1 * x1; }
                    }
                    if (epi == EPI_RELU2) __builtin_nontemporal_store(pack8(v0, v1), (u32x4*)(rowp + bj * HALF));
                    else *(u32x4*)(rowp + bj * HALF) = pack8(v0, v1);
                }
            }
    } break;
    case EPI_SDECAY: { if (!((EPI_MASK >> EPI_SDECAY) & 1)) break;
        J.out = (u.z >= 16) ? (bf16_t*)ap->out : (bf16_t*)(ws + WS_R3); J.ldc = 2048; J.zC = (long)2048 * 2048; J.f0 = (const float*)(ws + WS_DEC);
        const int h = u.z & 3;
        const float lf = J.f0[h], lb = J.f0[4 + h];
        bf16_t* base = J.out + (size_t)(u.z & 15) * J.zC + u.pn * BM + colb;
        if (u.pm == u.pn) {
#pragma unroll
            for (int ai = 0; ai < 2; ++ai)
#pragma unroll
                for (int m = 0; m < 4; ++m) {
                    const int row = rowb + ai * HALF + m * 16;
                    bf16_t* rowp = base + (size_t)row * J.ldc;
#pragma unroll
                    for (int bj = 0; bj < 2; ++bj) {
                        const int col = u.pn * BM + bj * HALF + colb;
                        f32x4 v0 = acc[ai][bj][m][0], v1 = acc[ai][bj][m][1];
#pragma unroll
                        for (int i = 0; i < 4; ++i) {
                            const int d0 = row - (col + i), d1 = row - (col + 4 + i);
                            v0[i] *= __builtin_amdgcn_exp2f(d0 >= 0 ? lf * (float)d0 : lb * (float)(-d0));
                            v1[i] *= __builtin_amdgcn_exp2f(d1 >= 0 ? lf * (float)d1 : lb * (float)(-d1));
                        }
                        *(u32x4*)(rowp + bj * HALF) = pack8(v0, v1);
                    }
                }
        } else {
            const bool below = u.pm > u.pn; const int R0 = u.pm * BM, C0 = u.pn * BM; const float lg = below ? lf : lb;
            f32x4 cf[2][2];
#pragma unroll
            for (int bj = 0; bj < 2; ++bj)
#pragma unroll
                for (int n = 0; n < 2; ++n)
#pragma unroll
                    for (int i = 0; i < 4; ++i) { const int col = C0 + bj * HALF + colb + 4 * n + i; cf[bj][n][i] = __builtin_amdgcn_exp2f(lg * (float)(below ? (R0 - col) : (col - C0))); }
#pragma unroll
            for (int ai = 0; ai < 2; ++ai)
#pragma unroll
                for (int m = 0; m < 4; ++m) {
                    const int row = rowb + ai * HALF + m * 16;
                    const float rf = __builtin_amdgcn_exp2f(lg * (float)(below ? (row - R0) : (C0 - row)));
                    bf16_t* rowp = base + (size_t)row * J.ldc;
#pragma unroll
                    for (int bj = 0; bj < 2; ++bj)
                        *(u32x4*)(rowp + bj * HALF) = pack8(acc[ai][bj][m][0] * (cf[bj][0] * rf), acc[ai][bj][m][1] * (cf[bj][1] * rf));
                }
        }
    } break;
    case EPI_OY: { if (!((EPI_MASK >> EPI_OY) & 1)) break;
        J.out = (bf16_t*)(ws + WS_R1); J.s0 = (float*)(ws + WS_GN);
        const int b = var + (u.z >> 2), h = u.z & 3;
#pragma unroll
        for (int ai = 0; ai < 2; ++ai)
#pragma unroll
            for (int m = 0; m < 4; ++m) {
                const int row = rowb + ai * HALF + m * 16; const size_t tok = (size_t)b * 2048 + row;
                bf16_t* rowp = J.out + tok * 2048 + h * 512 + u.pn * BM + colb;
                float s1 = 0.f, s2 = 0.f;
#pragma unroll
                for (int bj = 0; bj < 2; ++bj) {
                    const f32x4 v0 = acc[ai][bj][m][0], v1 = acc[ai][bj][m][1];
#pragma unroll
                    for (int i = 0; i < 4; ++i) { s1 += v0[i] + v1[i]; s2 += v0[i] * v0[i] + v1[i] * v1[i]; }
                    *(u32x4*)(rowp + bj * HALF) = pack8(v0, v1);
                }
                s1 += __shfl_xor(s1, 16); s1 += __shfl_xor(s1, 32); s2 += __shfl_xor(s2, 16); s2 += __shfl_xor(s2, 32);
                if (fq == 0) { float* g = J.s0 + (tok * 4 + h) * 2; atomicAdd(g, s1); atomicAdd(g + 1, s2); }
                EPI_FENCE();
            }
    } break;
    case EPI_GATE: { if (!((EPI_MASK >> EPI_GATE) & 1)) break;
        J.out = (bf16_t*)(ws + WS_R1); J.f0 = (const float*)(ws + WS_GN); J.f1 = ap->in[9];
        const int h = u.pn >> 1;
        f32x4 gw[2][2];
#pragma unroll
        for (int bj = 0; bj < 2; ++bj)
#pragma unroll
            for (int n = 0; n < 2; ++n) gw[bj][n] = *(const f32x4*)(J.f1 + u.pn * BM + bj * HALF + colb + 4 * n);
#pragma unroll
        for (int ai = 0; ai < 2; ++ai) {
            f32x2 st[4]; u32x4 yv[4][2];
#pragma unroll
            for (int m = 0; m < 4; ++m) {
                const size_t tok = (size_t)(rowb + ai * HALF + m * 16);
                st[m] = *(const f32x2*)(J.f0 + (tok * 4 + h) * 2);
                const bf16_t* rowp = J.out + tok * 2048 + u.pn * BM + colb;
                yv[m][0] = *(const u32x4*)(rowp); yv[m][1] = *(const u32x4*)(rowp + HALF);
            }
#pragma unroll
            for (int m = 0; m < 4; ++m) {
                const size_t tok = (size_t)(rowb + ai * HALF + m * 16);
                const float mu = st[m][0] * (1.0f / 512.0f); const float var = st[m][1] * (1.0f / 512.0f) - mu * mu;
                const float rstd = 1.0f / sqrtf(fmaxf(var, 0.f) + 1e-5f);
                bf16_t* rowp = J.out + tok * 2048 + u.pn * BM + colb;
#pragma unroll
                for (int bj = 0; bj < 2; ++bj) {
                    const u32x4 yw = yv[m][bj];
                    const f32x4 a0 = acc[ai][bj][m][0], a1 = acc[ai][bj][m][1];
                    f32x4 y0, y1, o0, o1;
                    y0[0] = bf2f(yw.x & 0xffffu); y0[1] = bf2f(yw.x >> 16); y0[2] = bf2f(yw.y & 0xffffu); y0[3] = bf2f(yw.y >> 16);
                    y1[0] = bf2f(yw.z & 0xffffu); y1[1] = bf2f(yw.z >> 16); y1[2] = bf2f(yw.w & 0xffffu); y1[3] = bf2f(yw.w >> 16);
#pragma unroll
                    for (int i = 0; i < 4; ++i) {
                        const float sg0 = a0[i] * __builtin_amdgcn_rcpf(1.0f + __expf(-a0[i])), sg1 = a1[i] * __builtin_amdgcn_rcpf(1.0f + __expf(-a1[i]));
                        o0[i] = sg0 * ((y0[i] - mu) * rstd * gw[bj][0][i]); o1[i] = sg1 * ((y1[i] - mu) * rstd * gw[bj][1][i]);
                    }
                    *(u32x4*)(rowp + bj * HALF) = pack8(o0, o1);
                }
            }
            EPI_FENCE();
        }
    } break;
    case EPI_WIN: { if (!((EPI_MASK >> EPI_WIN) & 1)) break;
        J.out = (bf16_t*)(ws + WS_R3); J.s0 = (float*)(ws + WS_SSQQ); J.s1 = (float*)(ws + WS_SSQKV);
#pragma unroll
        for (int ai = 0; ai < 2; ++ai)
#pragma unroll
            for (int m = 0; m < 4; ++m) {
                const int row = rowb + ai * HALF + m * 16;
                bf16_t* rowp = J.out + (size_t)row * 768 + u.pn * BM + colb;
                float sq = 0.f, skv = 0.f;
#pragma unroll
                for (int bj = 0; bj < 2; ++bj) {
                    const f32x4 v0 = acc[ai][bj][m][0], v1 = acc[ai][bj][m][1];
                    float s = 0.f;
#pragma unroll
                    for (int i = 0; i < 4; ++i) s += v0[i] * v0[i] + v1[i] * v1[i];
                    const int reg = u.pn * 2 + bj;
                    if (reg < 3) sq += s; else if (reg < 5) skv += s;
                    *(u32x4*)(rowp + bj * HALF) = pack8(v0, v1);
                }
                sq += __shfl_xor(sq, 16); sq += __shfl_xor(sq, 32); skv += __shfl_xor(skv, 16); skv += __shfl_xor(skv, 32);
                if (fq == 0) { if (u.pn < 2) atomicAdd(J.s0 + row, sq); if (u.pn > 0) atomicAdd(J.s1 + row, skv); }
                EPI_FENCE();
            }
    } break;
    case EPI_UQ: { if (!((EPI_MASK >> EPI_UQ) & 1)) break;
        J.out = (bf16_t*)(ws + WS_R1); J.f0 = (const float*)(ws + WS_SSQQ); J.f1 = (const float*)(ws + WS_R3 + 64 * MiB);
#pragma unroll
        for (int ai = 0; ai < 2; ++ai)
#pragma unroll
            for (int m = 0; m < 4; ++m) {
                const int row = rowb + ai * HALF + m * 16;
                const float rstd = 1.0f / sqrtf(J.f0[row] * (1.0f / 384.0f) + 1e-6f);
                bf16_t* qrow = J.out + (size_t)row * 1536;
                if (u.pn < 4) {
#pragma unroll
                    for (int bj = 0; bj < 2; ++bj) {
                        const int hd = u.pn * 2 + bj;
                        *(u32x4*)(qrow + hd * 192 + colb) = pack8(acc[ai][bj][m][0] * rstd, acc[ai][bj][m][1] * rstd);
                    }
                } else {
                    const int hd = (u.pn - 4) * 4 + wc; const int j0 = 8 * fq;
                    const f32x4* tp = (const f32x4*)(J.f1 + ((size_t)row * 32 + j0) * 2);
                    const f32x4 t0 = tp[0], t1 = tp[1], t2 = tp[2], t3 = tp[3];
                    const f32x4 a0 = acc[ai][0][m][0] * rstd, a1 = acc[ai][0][m][1] * rstd, b0 = acc[ai][1][m][0] * rstd, b1 = acc[ai][1][m][1] * rstd;
                    f32x4 o0, o1, p0, p1;
                    o0[0] = a0[0] * t0[0] - b0[0] * t0[1]; p0[0] = a0[0] * t0[1] + b0[0] * t0[0];
                    o0[1] = a0[1] * t0[2] - b0[1] * t0[3]; p0[1] = a0[1] * t0[3] + b0[1] * t0[2];
                    o0[2] = a0[2] * t1[0] - b0[2] * t1[1]; p0[2] = a0[2] * t1[1] + b0[2] * t1[0];
                    o0[3] = a0[3] * t1[2] - b0[3] * t1[3]; p0[3] = a0[3] * t1[3] + b0[3] * t1[2];
                    o1[0] = a1[0] * t2[0] - b1[0] * t2[1]; p1[0] = a1[0] * t2[1] + b1[0] * t2[0];
                    o1[1] = a1[1] * t2[2] - b1[1] * t2[3]; p1[1] = a1[1] * t2[3] + b1[1] * t2[2];
                    o1[2] = a1[2] * t3[0] - b1[2] * t3[1]; p1[2] = a1[2] * t3[1] + b1[2] * t3[0];
                    o1[3] = a1[3] * t3[2] - b1[3] * t3[3]; p1[3] = a1[3] * t3[3] + b1[3] * t3[2];
                    *(u32x4*)(qrow + hd * 192 + 128 + j0) = pack8(o0, o1); *(u32x4*)(qrow + hd * 192 + 160 + j0) = pack8(p0, p1);
                }
                EPI_FENCE();
            }
    } break;
    case EPI_UKV: { if (!((EPI_MASK >> EPI_UKV) & 1)) break;
        J.out = (bf16_t*)(ws + WS_R1) + (size_t)T_TOK * 1536; J.out2 = (bf16_t*)(ws + WS_R1) + (size_t)2 * T_TOK * 1536; J.f0 = (const float*)(ws + WS_SSQKV); J.f1 = (const float*)(ws + WS_R3 + 64 * MiB); J.b0 = (bf16_t*)(ws + WS_R3);
        const int hd = u.pn;
#pragma unroll
        for (int ai = 0; ai < 2; ++ai)
#pragma unroll
            for (int m = 0; m < 4; ++m) {
                const int row = rowb + ai * HALF + m * 16;
                const float rstd = 1.0f / sqrtf(J.f0[row] * (1.0f / 256.0f) + 1e-6f);
                bf16_t* krow = J.out + (size_t)row * 1536 + hd * 192;
                *(u32x4*)(krow + colb) = pack8(acc[ai][0][m][0] * rstd, acc[ai][0][m][1] * rstd);
                *(u32x4*)(J.out2 + (size_t)row * 1024 + hd * 128 + colb) = pack8(acc[ai][1][m][0] * rstd, acc[ai][1][m][1] * rstd);
                const int j = wc * 8 + fq * 2;
                const unsigned c1 = *(const unsigned*)(J.b0 + (size_t)row * 768 + 640 + j), c2 = *(const unsigned*)(J.b0 + (size_t)row * 768 + 672 + j);
                const f32x4 t = *(const f32x4*)(J.f1 + ((size_t)row * 32 + j) * 2);
                const float x0 = bf2f(c1 & 0xffffu), x1 = bf2f(c1 >> 16), y0 = bf2f(c2 & 0xffffu), y1 = bf2f(c2 >> 16);
                *(unsigned*)(krow + 128 + j) = cvt_pk_bf16(x0 * t[0] - y0 * t[1], x1 * t[2] - y1 * t[3]);
                *(unsigned*)(krow + 160 + j) = cvt_pk_bf16(x0 * t[1] + y0 * t[0], x1 * t[3] + y1 * t[2]);
                EPI_FENCE();
            }
    } break;
    default: break;
    }
}

__device__ __forceinline__ void gemm_phase(LAS unsigned char* lds, const GemmJob& g, const Sched& S, ArgsP ap, const int tid_in) {
    int tid = threadIdx.x; asm volatile("" : "+v"(tid)); (void)tid_in;
    const int wid = __builtin_amdgcn_readfirstlane(tid >> 6), lane = tid & 63, wr = wid >> 2, wc = wid & 3, fr = lane & 15, fq = lane >> 4;
    const int nt = g.K / BK;
    unsigned voffA[2], voffB[2];
#pragma unroll
    for (int i = 0; i < 2; ++i) { int R, C; stage_rc(tid * 16 + i * 8192, R, C); const int Rb = (R & ~31) + perm32(R & 31);
        voffA[i] = (unsigned)(R * g.lda + C) * 2u; voffB[i] = (unsigned)(Rb * g.ldb + C) * 2u; }
    const size_t kstep = (size_t)(BK * 2);
    const size_t hstepA = (size_t)HALF * g.lda * 2, hstepB = (size_t)HALF * g.ldb * 2;
    const unsigned ldsw = (unsigned)wid * 1024u;
    const int aoff = lds_byte(wr * 64 + fr, fq * 8), boff = lds_byte(wc * 32 + fr, fq * 8);
#define PG8_SA(b, h) (((b) * 2 + (h)) * HTB)
#define PG8_SB(b, h) ((4 + (b) * 2 + (h)) * HTB)
#define PG8_STAGE(bufoff, gbase, voff) do { _Pragma("unroll") for (int _i = 0; _i < 2; ++_i) \
        __builtin_amdgcn_global_load_lds((const unsigned*)((const char*)(gbase) + (voff)[_i]), (LAS unsigned*)(lds + (bufoff) + ldsw + _i * 8192), 16, 0, 0); } while (0)
#define PG8_LDA(dst, b, h) do { _Pragma("unroll") for (int m = 0; m < 4; ++m) _Pragma("unroll") for (int k = 0; k < 2; ++k) dst[m][k] = *(const LAS bf16x8*)(lds + PG8_SA(b, h) + aoff + m * 2048 + k * 1024); } while (0)
#define PG8_LDB(dst, b, h) do { _Pragma("unroll") for (int n = 0; n < 2; ++n) _Pragma("unroll") for (int k = 0; k < 2; ++k) dst[n][k] = *(const LAS bf16x8*)(lds + PG8_SB(b, h) + boff + n * 2048 + k * 1024); } while (0)
#define PG8_MMA(ai, bj, At, Bt) do { __builtin_amdgcn_s_setprio(1); _Pragma("unroll") for (int m = 0; m < 4; ++m) _Pragma("unroll") for (int n = 0; n < 2; ++n) _Pragma("unroll") for (int k = 0; k < 2; ++k) \
        acc[ai][bj][m][n] = __builtin_amdgcn_mfma_f32_16x16x32_bf16(Bt[n][k], At[m][k], acc[ai][bj][m][n], 0, 0, 0); __builtin_amdgcn_s_setprio(0); } while (0)
#define PG8_WAIT_V(n) asm volatile("s_waitcnt vmcnt(" #n ")" ::: "memory")
#define PG8_WAIT_L(n) asm volatile("s_waitcnt lgkmcnt(" #n ")" ::: "memory")
#define PG8_BAR __builtin_amdgcn_s_barrier()
#define PG8_SCHED __builtin_amdgcn_sched_barrier(0)
#define PG8_PTRA(u) ((const char*)g.A + 2 * ((size_t)((u).z / g.zdiv) * g.zAh + (size_t)((u).z % g.zdiv) * g.zAl + (size_t)(u).pm * BM * g.lda))
#define PG8_PTRB(u) ((const char*)g.Bt + 2 * ((size_t)((u).z / g.zdiv) * g.zBh + (size_t)((u).z % g.zdiv) * g.zBl + (size_t)(u).pn * BM * g.ldb))
    Unit cur, nxt; int ui = 0;
    if (!S.next(0, cur)) return;
    Acc acc;
#pragma unroll
    for (int a = 0; a < 2; ++a)
#pragma unroll
        for (int b = 0; b < 2; ++b)
#pragma unroll
            for (int m = 0; m < 4; ++m)
#pragma unroll
                for (int n = 0; n < 2; ++n) acc[a][b][m][n] = (f32x4){0.f, 0.f, 0.f, 0.f};
    bf16x8 At[4][2], B0[2][2], B1[2][2];
    const char* cA = PG8_PTRA(cur); const char* cB = PG8_PTRB(cur);
    PG8_STAGE(PG8_SB(0, 0), cB, voffB); PG8_STAGE(PG8_SB(0, 1), cB + hstepB, voffB); PG8_STAGE(PG8_SA(0, 0), cA, voffA); PG8_STAGE(PG8_SA(0, 1), cA + hstepA, voffA);
    PG8_STAGE(PG8_SB(1, 0), cB + kstep, voffB); PG8_STAGE(PG8_SA(1, 0), cA + kstep, voffA); PG8_STAGE(PG8_SB(1, 1), cB + hstepB + kstep, voffB);
    if (wr == 1) PG8_BAR;
    PG8_WAIT_V(8); PG8_BAR;
    PG8_WAIT_V(6); PG8_BAR;
    for (;;) {
        const bool has_next = S.next(ui + 1, nxt);
        const char* nA = cA; const char* nB = cB;
        if (has_next) { nA = PG8_PTRA(nxt); nB = PG8_PTRB(nxt); }
        for (int t = 0; t < nt; t += 2) {
            const bool last = (t == nt - 2);
            const char* a1 = cA + (size_t)(t + 1) * kstep;
            const char* a2 = last ? nA : cA + (size_t)(t + 2) * kstep; const char* b2 = last ? nB : cB + (size_t)(t + 2) * kstep;
            const char* a3 = a2 + kstep; const char* b3 = b2 + kstep;
            PG8_LDB(B0, 0, 0); PG8_LDB(B1, 0, 1); PG8_SCHED; PG8_LDA(At, 0, 0); PG8_STAGE(PG8_SA(1, 1), a1 + hstepA, voffA);
            PG8_WAIT_V(8); PG8_WAIT_L(0); PG8_BAR; PG8_MMA(0, 0, At, B0); PG8_MMA(0, 1, At, B1); PG8_BAR; PG8_SCHED;
            PG8_LDA(At, 0, 1); PG8_STAGE(PG8_SB(0, 0), b2, voffB); PG8_STAGE(PG8_SB(0, 1), b2 + hstepB, voffB); PG8_STAGE(PG8_SA(0, 0), a2, voffA);
            PG8_WAIT_V(8); PG8_WAIT_L(0); PG8_BAR; PG8_MMA(1, 0, At, B0); PG8_MMA(1, 1, At, B1); PG8_BAR; PG8_SCHED;
            PG8_LDB(B0, 1, 0); PG8_LDB(B1, 1, 1); PG8_SCHED; PG8_LDA(At, 1, 0); PG8_STAGE(PG8_SA(0, 1), a2 + hstepA, voffA);
            PG8_WAIT_V(8); PG8_WAIT_L(0); PG8_BAR; PG8_MMA(0, 0, At, B0); PG8_MMA(0, 1, At, B1); PG8_BAR; PG8_SCHED;
            PG8_LDA(At, 1, 1); PG8_STAGE(PG8_SB(1, 0), b3, voffB); PG8_STAGE(PG8_SB(1, 1), b3 + hstepB, voffB); PG8_STAGE(PG8_SA(1, 0), a3, voffA);
            PG8_WAIT_V(8); PG8_WAIT_L(0); PG8_BAR; PG8_MMA(1, 0, At, B0); PG8_MMA(1, 1, At, B1); PG8_BAR; PG8_SCHED;
        }
        if (wr == 0) PG8_BAR;
        epilogue(acc, cur, wr, wc, fr, fq, g.epi, g.var, ap);
        if (!has_next) break;
#pragma unroll
        for (int a = 0; a < 2; ++a)
#pragma unroll
            for (int b = 0; b < 2; ++b)
#pragma unroll
                for (int m = 0; m < 4; ++m)
#pragma unroll
                    for (int n = 0; n < 2; ++n) acc[a][b][m][n] = (f32x4){0.f, 0.f, 0.f, 0.f};
        cur = nxt; cA = nA; cB = nB; ++ui;
        if (wr == 1) PG8_BAR;
    }
    PG8_WAIT_V(0);
    PG8_BAR;
#undef PG8_SA
#undef PG8_SB
#undef PG8_STAGE
#undef PG8_LDA
#undef PG8_LDB
#undef PG8_MMA
#undef PG8_WAIT_V
#undef PG8_WAIT_L
#undef PG8_BAR
#undef PG8_SCHED
#undef PG8_PTRA
#undef PG8_PTRB
}

namespace mla {
constexpr int LDQ = 1536, LDK = 1536, LDV = 1024, LDO = 1024;
constexpr int KT_BYTES = 64 * 192 * 2, VT_BYTES = 64 * 128 * 2;
constexpr int V_OFF = 0, K_OFF = 2 * VT_BYTES, WS_OFF = K_OFF + 2 * KT_BYTES;
constexpr float SCALE = 0.07216878364870322f;
constexpr float THR = 8.f;
#define KSWZ(row, colB) ((row) * 384 + ((colB) ^ (((row) & 7) << 4)))
#define SBAR() __builtin_amdgcn_sched_barrier(0)
__device__ __forceinline__ int crow(int r, int hi) { return (r & 3) + 8 * (r >> 2) + 4 * hi; }
__device__ __forceinline__ void partialSM(f32x16& p0, f32x16& p1, float& m_reg, float& mn, float& alpha) {
    constexpr float C = SCALE * 1.4426950408889634f;
    float pmax = p0[0];
#pragma unroll
    for (int r = 1; r < 16; ++r) pmax = fmaxf(pmax, p0[r]);
#pragma unroll
    for (int r = 0; r < 16; ++r) pmax = fmaxf(pmax, p1[r]);
    { auto rr = __builtin_amdgcn_permlane32_swap(__float_as_uint(pmax), __float_as_uint(pmax), false, false);
      pmax = fmaxf(__uint_as_float(rr[0]), __uint_as_float(rr[1])); }
    if (__builtin_expect(__all(pmax - m_reg <= THR / SCALE), 1)) { mn = m_reg; alpha = 1.f; }
    else { mn = fmaxf(m_reg, pmax); alpha = __builtin_amdgcn_exp2f((m_reg - mn) * C); m_reg = mn; }
    const float mnC = -mn * C;
#pragma unroll
    for (int r = 0; r < 16; ++r) p0[r] = __builtin_amdgcn_exp2f(fmaf(p0[r], C, mnC));
#pragma unroll
    for (int r = 0; r < 16; ++r) p1[r] = __builtin_amdgcn_exp2f(fmaf(p1[r], C, mnC));
}
__device__ __forceinline__ void finishSM(f32x16& p0, f32x16& p1, float alpha, float& l_reg, bf16x8& pa0, bf16x8& pa1, bf16x8& pa2, bf16x8& pa3) {
    float ps = 0;
#pragma unroll
    for (int r = 0; r < 16; ++r) ps += p0[r];
#pragma unroll
    for (int r = 0; r < 16; ++r) ps += p1[r];
    { auto rr = __builtin_amdgcn_permlane32_swap(__float_as_uint(ps), __float_as_uint(ps), false, false);
      ps = __uint_as_float(rr[0]) + __uint_as_float(rr[1]); }
    l_reg = l_reg * alpha + ps;
#define PK4(P, BASE, OUT) do { unsigned a0 = cvt_pk_bf16(P[BASE + 0], P[BASE + 1]), a1 = cvt_pk_bf16(P[BASE + 2], P[BASE + 3]);   \
    unsigned b0 = cvt_pk_bf16(P[BASE + 4], P[BASE + 5]), b1 = cvt_pk_bf16(P[BASE + 6], P[BASE + 7]);                              \
    auto r0 = __builtin_amdgcn_permlane32_swap(a0, b0, false, false); auto r1 = __builtin_amdgcn_permlane32_swap(a1, b1, false, false); \
    u32x4 w = {r0[0], r1[0], r0[1], r1[1]}; OUT = *reinterpret_cast<bf16x8*>(&w); } while (0)
    PK4(p0, 0, pa0); PK4(p0, 8, pa1); PK4(p1, 0, pa2); PK4(p1, 8, pa3);
#undef PK4
}
__device__ __forceinline__ int v_st(int k, int c) { const int kk = (k & ~0xC) | ((k & 4) << 1) | ((k & 8) >> 1); return ((kk >> 3) * 4 + (c >> 5)) * 512 + ((kk & 7) * 32 + (c & 31)) * 2; }
__device__ __forceinline__ int v_rd_base(int lane) { return ((lane & 3) << 3) | (((lane >> 2) & 3) << 6) | (((lane >> 4) & 1) << 5) | (((lane >> 5) & 1) << 8); }
constexpr int v_rd_off(int d0, int ks, int half) { return d0 * 512 + ks * 4096 + half * 2048; }
template <int OFF> __device__ __forceinline__ s16x4 tr_read(int vb) {
    s16x4 r; asm volatile("ds_read_b64_tr_b16 %0, %1 offset:%2" : "=&v"(r) : "v"(vb), "i"(OFF) : "memory"); return r;
}
template <int D0> __device__ __forceinline__ void pv_one(f32x16& od, int vb, bf16x8 pa0, bf16x8 pa1, bf16x8 pa2, bf16x8 pa3) {
    const s16x4 l0 = tr_read<v_rd_off(D0, 0, 0)>(vb), h0 = tr_read<v_rd_off(D0, 0, 1)>(vb), l1 = tr_read<v_rd_off(D0, 1, 0)>(vb), h1 = tr_read<v_rd_off(D0, 1, 1)>(vb);
    const s16x4 l2 = tr_read<v_rd_off(D0, 2, 0)>(vb), h2 = tr_read<v_rd_off(D0, 2, 1)>(vb), l3 = tr_read<v_rd_off(D0, 3, 0)>(vb), h3 = tr_read<v_rd_off(D0, 3, 1)>(vb);
    asm volatile("s_waitcnt lgkmcnt(0)" ::: "memory"); SBAR();
#define PK(L, H) (bf16x8){L[0], L[1], L[2], L[3], H[0], H[1], H[2], H[3]}
    od = __builtin_amdgcn_mfma_f32_32x32x16_bf16(pa0, PK(l0, h0), od, 0, 0, 0);
    od = __builtin_amdgcn_mfma_f32_32x32x16_bf16(pa1, PK(l1, h1), od, 0, 0, 0);
    od = __builtin_amdgcn_mfma_f32_32x32x16_bf16(pa2, PK(l2, h2), od, 0, 0, 0);
    od = __builtin_amdgcn_mfma_f32_32x32x16_bf16(pa3, PK(l3, h3), od, 0, 0, 0);
#undef PK
}
__device__ __forceinline__ void attn_unit(const bf16_t* __restrict__ Qb, const bf16_t* __restrict__ Kh, const bf16_t* __restrict__ Vh, bf16_t* __restrict__ Ob, char* lds, const int tid_in,
                                          const bf16_t* __restrict__ Kn, const bf16_t* __restrict__ Vn, const bool first) {
    int tid = threadIdx.x; asm volatile("" : "+v"(tid)); (void)tid_in;
    const int wid = tid >> 6, lane = tid & 63, r32 = lane & 31, hi = lane >> 5;
    char* V_lds = lds + V_OFF; char* K_lds = lds + K_OFF;
    float* ws = (float*)(lds + WS_OFF) + wid * 64; float* li_l = ws; float* al_l = ws + 32;
    float m_reg = -1e30f, l_reg = 0; f32x16 o0 = {}, o1 = {}, o2 = {}, o3 = {}; bf16x8 qr[12];
    const bf16_t* Qw = Qb + (size_t)(wid * 32 + r32) * LDQ + hi * 8;
#pragma unroll
    for (int d0 = 0; d0 < 12; ++d0) qr[d0] = *(const bf16x8*)(Qw + d0 * 16);
    LAS unsigned char* ldsl = (LAS unsigned char*)lds;
    unsigned kof[3], vof[2];
#pragma unroll
    for (int i = 0; i < 3; ++i) { const int p = (i * 8 + wid) * 64 + lane, row = p / 24, chs = p % 24, ch = (chs & ~7) | ((chs ^ row) & 7); kof[i] = (unsigned)(row * LDK + ch * 8) * 2u; }
#pragma unroll
    for (int i = 0; i < 2; ++i) { const int p = (i * 8 + wid) * 64 + lane, sub = p >> 5, kkh = sub >> 2, chh = sub & 3, kkl = (p & 31) >> 2, cl = (p & 3) * 8;
        const int kk = kkh * 8 + kkl, k = (kk & ~0xC) | ((kk & 4) << 1) | ((kk & 8) >> 1), c = chh * 32 + cl; vof[i] = (unsigned)(k * LDV + c) * 2u; }
    const int vb0 = (int)(uintptr_t)V_lds + v_rd_base(lane);
    const int wofs = __builtin_amdgcn_readfirstlane(wid) * 1024;
#define SDMA(KP, VP, k0, b) do { \
    _Pragma("unroll") for (int _i = 0; _i < 3; ++_i) __builtin_amdgcn_global_load_lds((const unsigned*)((const char*)(KP) + (size_t)(k0) * LDK * 2 + kof[_i]), (LAS unsigned*)(ldsl + K_OFF + (b) * KT_BYTES + _i * 8192 + wofs), 16, 0, 0); \
    _Pragma("unroll") for (int _i = 0; _i < 2; ++_i) __builtin_amdgcn_global_load_lds((const unsigned*)((const char*)(VP) + (size_t)(k0) * LDV * 2 + vof[_i]), (LAS unsigned*)(ldsl + V_OFF + (b) * VT_BYTES + _i * 8192 + wofs), 16, 0, 0); } while (0)
    constexpr int NT = SEQ / 64;
    if (first) SDMA(Kh, Vh, 0, 0);
    asm volatile("s_waitcnt vmcnt(0)" ::: "memory"); __syncthreads();
    for (int j = 0; j < NT; ++j) {
        const int cur = j & 1;
        if (j + 1 < NT) SDMA(Kh, Vh, (j + 1) * 64, cur ^ 1);
        else if (Kn) SDMA(Kn, Vn, 0, cur ^ 1);
        f32x16 p0 = {}, p1 = {};
        const char* Ks = K_lds + cur * KT_BYTES;
#pragma unroll
        for (int d0 = 0; d0 < 12; ++d0) { const int cb = (d0 * 16 + hi * 8) * 2;
            const bf16x8 b0 = *(const bf16x8*)(Ks + KSWZ(r32, cb));
            const bf16x8 b1 = *(const bf16x8*)(Ks + KSWZ(32 + r32, cb));
            p0 = __builtin_amdgcn_mfma_f32_32x32x16_bf16(b0, qr[d0], p0, 0, 0, 0);
            p1 = __builtin_amdgcn_mfma_f32_32x32x16_bf16(b1, qr[d0], p1, 0, 0, 0); }
        float mn, alpha; bf16x8 pa0, pa1, pa2, pa3;
        partialSM(p0, p1, m_reg, mn, alpha);
        if (__any(alpha < 1.f)) { if (hi == 0) al_l[r32] = alpha; asm volatile("s_waitcnt lgkmcnt(0)" ::: "memory");
#pragma unroll
            for (int r = 0; r < 16; ++r) { const float a = al_l[crow(r, hi)]; o0[r] *= a; o1[r] *= a; o2[r] *= a; o3[r] *= a; } }
        finishSM(p0, p1, alpha, l_reg, pa0, pa1, pa2, pa3);
        const int vb = vb0 + cur * VT_BYTES;
        pv_one<0>(o0, vb, pa0, pa1, pa2, pa3); pv_one<1>(o1, vb, pa0, pa1, pa2, pa3); pv_one<2>(o2, vb, pa0, pa1, pa2, pa3); pv_one<3>(o3, vb, pa0, pa1, pa2, pa3);
        asm volatile("s_waitcnt vmcnt(0)" ::: "memory");
        __syncthreads();
    }
    if (hi == 0) li_l[r32] = l_reg; asm volatile("s_waitcnt lgkmcnt(0)" ::: "memory");
    bf16_t* Ow = Ob + (size_t)(wid * 32) * LDO;
#pragma unroll
    for (int r = 0; r < 16; ++r) { const int orow = crow(r, hi); const float rl = __builtin_amdgcn_rcpf(li_l[orow]);
        bf16_t* op = Ow + (size_t)orow * LDO + r32;
        op[0] = (bf16_t)(cvt_pk_bf16(o0[r] * rl, 0.f) & 0xffffu); op[32] = (bf16_t)(cvt_pk_bf16(o1[r] * rl, 0.f) & 0xffffu);
        op[64] = (bf16_t)(cvt_pk_bf16(o2[r] * rl, 0.f) & 0xffffu); op[96] = (bf16_t)(cvt_pk_bf16(o3[r] * rl, 0.f) & 0xffffu); }
    __syncthreads();
#undef SDMA
}
}


template <int MODE>
__device__ __forceinline__ void tr_item(const float* W, int K, int Nsrc, bf16_t* WT, int nrow0, int srccol0, bool zero, const float* kscale, int k0, LAS float* scr, int lane, float (&v)[32]) {
    if (MODE == 0) {
#pragma unroll
        for (int i = 0; i < 32; ++i) { const int kk = 2 * i + (lane >> 5);
            float x = 0.f; if (!zero) { x = __builtin_nontemporal_load(W + (size_t)(k0 + kk) * Nsrc + srccol0 + (lane & 31)); if (kscale) x *= kscale[k0 + kk]; }
            v[i] = x; }
    } else {
        const int c = lane & 7;
#pragma unroll
        for (int j = 0; j < 4; ++j) { const int n = (lane >> 3) + 8 * j; const LAS float* s = scr + (8 * c) * 33 + n;
            u32x4 o; o.x = cvt_pk_bf16(s[0 * 33], s[1 * 33]); o.y = cvt_pk_bf16(s[2 * 33], s[3 * 33]); o.z = cvt_pk_bf16(s[4 * 33], s[5 * 33]); o.w = cvt_pk_bf16(s[6 * 33], s[7 * 33]);
            *(u32x4*)(WT + (size_t)(nrow0 + n) * K + k0 + 8 * c) = o; }
        asm volatile("s_waitcnt lgkmcnt(0)" ::: "memory");
    }
}
template <int MODE>
__device__ __forceinline__ void tr_matrix_item(int it, ArgsP a, LAS float* scr, int lane, float (&v)[32]) {
    constexpr int C0 = 16 * 192, C1 = C0 + 32 * 32, C2 = C1 + 16 * 24, C3 = C2 + 6 * 48, C4 = C3 + 4 * 64, C5 = C4 + 16 * 32, C6 = C5 + 16 * 128, C7 = C6 + 16 * 128, C8 = C7 + 64 * 32;
    int item, id;
    if (it < C0) { id = 0; item = it; } else if (it < C1) { id = 1; item = it - C0; } else if (it < C2) { id = 2; item = it - C1; } else if (it < C3) { id = 3; item = it - C2; }
    else if (it < C4) { id = 4; item = it - C3; } else if (it < C5) { id = 5; item = it - C4; } else if (it < C6) { id = 6; item = it - C5; } else if (it < C7) { id = 7; item = it - C6; }
    else if (it < C8) { id = 8; item = it - C7; } else { id = 9; item = it - C8; }
    const float* W; int K, Nsrc, Ndst; bf16_t* WT; const float* ksc = nullptr;
    unsigned char* ws = a->ws;
    switch (id) {
    case 0: W = a->in[6]; K = 1024; Nsrc = 6144; Ndst = 6144; WT = (bf16_t*)(ws + WS_RWIN); break;
    case 1: W = a->in[10]; K = 2048; Nsrc = 1024; Ndst = 1024; WT = (bf16_t*)(ws + WS_RWOUT); break;
    case 2: W = a->in[11]; K = 1024; Nsrc = 704; Ndst = 768; WT = (bf16_t*)(ws + WS_MWIN); break;
    case 3: W = a->in[13]; K = 384; Nsrc = 1536; Ndst = 1536; WT = (bf16_t*)(ws + WS_MWUQ); ksc = a->in[12]; break;
    case 4: W = a->in[15]; K = 256; Nsrc = 2048; Ndst = 2048; WT = (bf16_t*)(ws + WS_MWUKV); ksc = a->in[14]; break;
    case 5: W = a->in[16]; K = 1024; Nsrc = 1024; Ndst = 1024; WT = (bf16_t*)(ws + WS_MWOUT); break;
    case 6: W = a->in[17]; K = 1024; Nsrc = 4096; Ndst = 4096; WT = (bf16_t*)(ws + WS_W1); break;
    case 7: W = a->in[17] + (size_t)1024 * 4096; K = 1024; Nsrc = 4096; Ndst = 4096; WT = (bf16_t*)(ws + WS_W1) + (size_t)4096 * 1024; break;
    case 8: W = a->in[18]; K = 4096; Nsrc = 1024; Ndst = 1024; WT = (bf16_t*)(ws + WS_W2); break;
    default: W = a->in[18] + (size_t)4096 * 1024; K = 4096; Nsrc = 1024; Ndst = 1024; WT = (bf16_t*)(ws + WS_W2) + (size_t)1024 * 4096; break;
    }
    const int nblk = Ndst / 32, kb = item / nblk, nb = item % nblk, n0 = nb * 32;
    int src0 = n0; bool zero = false;
    if (id == 2) zero = (n0 >= 704);
    if (id == 3) {
        if (n0 < 1024) { src0 = (n0 >> 7) * 192 + (n0 & 127); }
        else { const int r = n0 - 1024, t = r >> 8, cc = r & 255, half = cc >> 7, hh = (cc & 127) >> 5; src0 = (4 * t + hh) * 192 + 128 + half * 32; }
    }
    tr_item<MODE>(W, K, Nsrc, WT, n0, src0, zero, ksc, kb * 64, scr, lane, v);
}
__device__ __forceinline__ void prep_phase(ArgsP a, char* lds_g, int G, const int tid_in) {
    LAS unsigned char* lds = (LAS unsigned char*)lds_g;
    int tid = threadIdx.x; asm volatile("" : "+v"(tid)); (void)tid_in;
    const int lane = tid & 63, wave = tid >> 6;
    unsigned char* ws = a->ws;
    {
        LAS float* scr = (LAS float*)(lds + wave * 16384);
        const int gw = blockIdx.x * 8 + wave, NGW = G * 8;
        constexpr int C9 = 16 * 192 + 32 * 32 + 16 * 24 + 6 * 48 + 4 * 64 + 16 * 32 + 16 * 128 + 16 * 128 + 64 * 32 + 64 * 32;
        float v[32];
        int it = gw;
        if (it < C9) tr_matrix_item<0>(it, a, scr, lane, v);
        while (it < C9) {
#pragma unroll
            for (int i = 0; i < 32; ++i) scr[(2 * i + (lane >> 5)) * 33 + (lane & 31)] = v[i];
            asm volatile("s_waitcnt lgkmcnt(0)" ::: "memory");
            const int nxt = it + NGW;
            if (nxt < C9) tr_matrix_item<0>(nxt, a, scr, lane, v);
            tr_matrix_item<1>(it, a, scr, lane, v);
            it = nxt;
        }
    }
    __syncthreads();
    {
        LAS float* cact = (LAS float*)lds; LAS float* red = (LAS float*)(lds + 65536);
        const float* c = a->in[1];
        for (int i = tid; i < 16384; i += 512) { const float v = c[i]; cact[i] = v / (1.0f + __expf(-v)); }
        __syncthreads();
        float* mod = (float*)(ws + WS_MOD);
        for (int u = blockIdx.x; u < 768; u += G) {
            const int l = u / 384, r_ = u % 384, cgp = r_ >> 2, kq = r_ & 3, col = cgp * 64 + lane;
            float accv[16];
#pragma unroll
            for (int b = 0; b < 16; ++b) accv[b] = 0.f;
            const int kb0 = kq * 256 + wave * 32;
            const float* w = a->in[4] + (size_t)l * 1024 * 6144 + (size_t)kb0 * 6144 + col;
            float wv[32];
#pragma unroll
            for (int k = 0; k < 32; ++k) wv[k] = __builtin_nontemporal_load(w + (size_t)k * 6144);
#pragma unroll
            for (int k = 0; k < 32; ++k) {
#pragma unroll
                for (int b = 0; b < 16; ++b) accv[b] = fmaf(cact[b * 1024 + kb0 + k], wv[k], accv[b]); }
#pragma unroll
            for (int b = 0; b < 16; ++b) red[(wave * 16 + b) * 64 + lane] = accv[b];
            __syncthreads();
            for (int o = tid; o < 1024; o += 512) { const int b = o >> 6, cc = o & 63; float s = 0.f;
#pragma unroll
                for (int kg = 0; kg < 8; ++kg) s += red[(kg * 16 + b) * 64 + cc];
                if (kq == 0) s += a->in[5][l * 6144 + cgp * 64 + cc];
                atomicAdd(&mod[(size_t)(l * 16 + b) * 6144 + cgp * 64 + cc], s); }
            __syncthreads();
        }
    }
    {
        const size_t gt = (size_t)blockIdx.x * 512 + tid, NT_ = (size_t)G * 512;
        const int* pos = (const int*)a->in[2];
        f32x2* tab = (f32x2*)(ws + WS_R3);
        for (size_t idx = gt; idx < (size_t)T_TOK * 128; idx += NT_) { const int t = (int)(idx >> 7), j = (int)(idx & 127);
            const float ang = (float)pos[t] * INVF_RET[j]; float s, c; sincos_f(ang, s, c);
            tab[idx] = (f32x2){c, s}; }
        float* z1 = (float*)(ws + WS_SSQQ); float* z2 = (float*)(ws + WS_SSQKV); float* z3 = (float*)(ws + WS_GN);
        for (size_t idx = gt; idx < (size_t)T_TOK; idx += NT_) { z1[idx] = 0.f; z2[idx] = 0.f; }
        for (size_t idx = gt; idx < (size_t)T_TOK * 8; idx += NT_) z3[idx] = 0.f;
        if (gt < 8) { const float x = (gt < 4) ? a->in[7][gt] : a->in[8][gt - 4]; ((float*)(ws + WS_DEC))[gt] = -log1pf(expf(-x)) * 1.4426950408889634f; }
    }
}

struct RowJob { const float* xin; const bf16_t* y; const float* wpost; const float* gate; float* xout; const float* wpre; const float* sc; const float* sh; bf16_t* hdn; int mla_tab; };
__device__ __forceinline__ void row_phase(const RowJob& R, ArgsP a, int G, const int tid_in) {
    int tid = threadIdx.x; asm volatile("" : "+v"(tid)); (void)tid_in;
    const int lane = tid & 63, wave = tid >> 6;
    const int gw = blockIdx.x * 8 + wave, NGW = G * 8;
    constexpr int RPW = 16;
    for (int chunk = gw; chunk < T_TOK / RPW; chunk += NGW) {
        const int row0 = chunk * RPW, b = row0 >> 11;
        f32x4 A1[4], B1[4], SH[4];
#pragma unroll
        for (int j = 0; j < 4; ++j) {
            if (R.y) { const f32x4 w = ((const f32x4*)R.wpost)[lane + 64 * j], g = ((const f32x4*)(R.gate + (size_t)b * 6144))[lane + 64 * j]; A1[j] = w * g; }
            else A1[j] = (f32x4){0.f, 0.f, 0.f, 0.f};
            if (R.hdn) { const f32x4 w = ((const f32x4*)R.wpre)[lane + 64 * j], sc = ((const f32x4*)(R.sc + (size_t)b * 6144))[lane + 64 * j]; B1[j] = w * (1.0f + sc); SH[j] = ((const f32x4*)(R.sh + (size_t)b * 6144))[lane + 64 * j]; }
            else { B1[j] = (f32x4){0.f, 0.f, 0.f, 0.f}; SH[j] = B1[j]; }
        }
        f32x4 v[4], vn[4]; u32x2 yw[4], ywn[4];
        {
            const f32x4* xr = (const f32x4*)(R.xin + (size_t)row0 * DM) + lane;
#pragma unroll
            for (int j = 0; j < 4; ++j) v[j] = __builtin_nontemporal_load(xr + 64 * j);
            if (R.y) { const u32x2* yr = (const u32x2*)(R.y + (size_t)row0 * DM) + lane;
#pragma unroll
                for (int j = 0; j < 4; ++j) yw[j] = __builtin_nontemporal_load(yr + 64 * j); }
        }
        for (int rr = 0; rr < RPW; ++rr) {
            const int row = row0 + rr;
            if (rr + 1 < RPW) {
                const f32x4* xr = (const f32x4*)(R.xin + (size_t)(row + 1) * DM) + lane;
#pragma unroll
                for (int j = 0; j < 4; ++j) vn[j] = __builtin_nontemporal_load(xr + 64 * j);
                if (R.y) { const u32x2* yr = (const u32x2*)(R.y + (size_t)(row + 1) * DM) + lane;
#pragma unroll
                    for (int j = 0; j < 4; ++j) ywn[j] = __builtin_nontemporal_load(yr + 64 * j); }
            }
            if (R.y) {
                f32x4 y[4]; float s = 0.f;
#pragma unroll
                for (int j = 0; j < 4; ++j) { const u32x2 w = yw[j]; y[j][0] = bf2f(w.x & 0xffffu); y[j][1] = bf2f(w.x >> 16); y[j][2] = bf2f(w.y & 0xffffu); y[j][3] = bf2f(w.y >> 16);
                    s += (y[j][0] * y[j][0] + y[j][1] * y[j][1]) + (y[j][2] * y[j][2] + y[j][3] * y[j][3]); }
                const float rstd = 1.0f / sqrtf(wave_sum(s) * (1.0f / DM) + 1e-6f);
                f32x4* xo = (f32x4*)(R.xout + (size_t)row * DM) + lane;
#pragma unroll
                for (int j = 0; j < 4; ++j) { v[j] = v[j] + (y[j] * rstd) * A1[j]; __builtin_nontemporal_store(v[j], xo + 64 * j); }
            }
            if (R.hdn) {
                float s = 0.f;
#pragma unroll
                for (int j = 0; j < 4; ++j) s += (v[j][0] * v[j][0] + v[j][1] * v[j][1]) + (v[j][2] * v[j][2] + v[j][3] * v[j][3]);
                const float rstd = 1.0f / sqrtf(wave_sum(s) * (1.0f / DM) + 1e-6f);
                u32x2* ho = (u32x2*)(R.hdn + (size_t)row * DM) + lane;
#pragma unroll
                for (int j = 0; j < 4; ++j) { const f32x4 h = (v[j] * rstd) * B1[j] + SH[j]; u32x2 o; o.x = cvt_pk_bf16(h[0], h[1]); o.y = cvt_pk_bf16(h[2], h[3]); ho[64 * j] = o; }
            }
#pragma unroll
            for (int j = 0; j < 4; ++j) { v[j] = vn[j]; yw[j] = ywn[j]; }
        }
    }
    if (R.mla_tab) {
        const size_t gt = (size_t)blockIdx.x * 512 + tid, NT_ = (size_t)G * 512;
        const int* pos = (const int*)a->in[2];
        f32x2* tab = (f32x2*)(a->ws + WS_R3 + 64 * MiB);
        for (size_t idx = gt; idx < (size_t)T_TOK * 32; idx += NT_) { const int t = (int)(idx >> 5), j = (int)(idx & 31);
            const float ang = (float)pos[t] * INVF_MLA[j]; float s, c; sincos_f(ang, s, c);
            tab[idx] = (f32x2){c, s}; }
    }
}


__device__ __forceinline__ void mla_table_half(ArgsP a, int G) {
    int tid = threadIdx.x; asm volatile("" : "+v"(tid));
    const int half = (G % 2 == 0) ? G / 2 : 0;
    if ((int)blockIdx.x < half) return;
    const size_t gt = (size_t)((int)blockIdx.x - half) * 512 + tid, NT_ = (size_t)(G - half) * 512;
    const int* pos = (const int*)a->in[2];
    f32x2* tab = (f32x2*)(a->ws + WS_R3 + 64 * MiB);
    for (size_t idx = gt; idx < (size_t)T_TOK * 32; idx += NT_) { const int t = (int)(idx >> 5), j = (int)(idx & 31);
        const float ang = (float)pos[t] * INVF_MLA[j]; float s, c; sincos_f(ang, s, c);
        tab[idx] = (f32x2){c, s}; }
}

#define XB_TMO      128
#define XB_XCNT(j)  (256  + 64 * (j))
#define XB_XSUB(j)  (1280 + 64 * (j))
#define XB_XGEN(j)  (2304 + 64 * (j))
#define XB_TOP      3328
#define XB_TOPGEN   3392
#define XCD_BAR_WORDS 3456
#define XB_SPIN_CAP (1u << 21)
__device__ __forceinline__ unsigned xb_ld(unsigned* p)              { return __hip_atomic_load(p, __ATOMIC_RELAXED, __HIP_MEMORY_SCOPE_AGENT); }
__device__ __forceinline__ unsigned xb_add(unsigned* p, unsigned v) { return __hip_atomic_fetch_add(p, v, __ATOMIC_RELAXED, __HIP_MEMORY_SCOPE_AGENT); }
__device__ __forceinline__ unsigned xb_xcc_id() { return (unsigned)__builtin_amdgcn_s_getreg((3 << 11) | 20) & 0xFu; }
#define XB_SPIN(cond, bar) do { unsigned _sp = 0; while (cond) { __builtin_amdgcn_s_sleep(1); \
    if ((++_sp & 255u) == 0u) { if (xb_ld(&(bar)[XB_TMO])) break; if (_sp > XB_SPIN_CAP) { atomicAdd(&(bar)[XB_TMO], 1u); break; } } } } while (0)
struct XcdBarrier { unsigned* bar; unsigned x; volatile LAS unsigned* st; };
__device__ __forceinline__ void xcd_barrier_complete(unsigned* bar, unsigned x, unsigned& nloc, unsigned& nx) {
    const unsigned G = gridDim.x * gridDim.y * gridDim.z;
    unsigned sum, cnt, mine, sp = 0u;
    for (;;) {
        sum = 0u; cnt = 0u; mine = 0u;
#pragma unroll
        for (unsigned j = 0; j < 16; ++j) { const unsigned c = xb_ld(&bar[XB_XCNT(j)]); sum += c; cnt += (c > 0u) ? 1u : 0u; mine = (j == x) ? c : mine; }
        if (sum == G) break;
        __builtin_amdgcn_s_sleep(1);
        if ((++sp & 255u) == 0u) { if (xb_ld(&bar[XB_TMO])) break; if (sp > XB_SPIN_CAP) { atomicAdd(&bar[XB_TMO], 1u); break; } }
    }
    nloc = mine > 0u ? mine : 1u; nx = cnt > 0u ? cnt : 1u;
}
__device__ __forceinline__ void xcd_barrier(const XcdBarrier& b) {
    asm volatile("s_waitcnt vmcnt(0)" ::: "memory");
    __syncthreads();
    if (threadIdx.x == 0) {
        unsigned* bar = b.bar;
        __builtin_amdgcn_s_waitcnt(0);
        unsigned nloc = b.st[0], nx = b.st[1];
        if (nloc == 0u) { xcd_barrier_complete(bar, b.x, nloc, nx); b.st[0] = nloc; b.st[1] = nx; }
        const unsigned old = xb_add(&bar[XB_XSUB(b.x)], 1u);
        const unsigned gen = old / nloc;
        if (old + 1u == (gen + 1u) * nloc) {
            __builtin_amdgcn_fence(__ATOMIC_RELEASE, "agent");
            asm volatile("s_waitcnt vmcnt(0)" ::: "memory");
            const unsigned og = xb_add(&bar[XB_TOP], 1u);
            const unsigned tg = og / nx;
            if (og + 1u == (tg + 1u) * nx) xb_add(&bar[XB_TOPGEN], 1u);
            else XB_SPIN(xb_ld(&bar[XB_TOPGEN]) == tg, bar);
            __builtin_amdgcn_fence(__ATOMIC_ACQUIRE, "agent");
            xb_add(&bar[XB_XGEN(b.x)], 1u);
            asm volatile("s_waitcnt vmcnt(0)" ::: "memory");
        } else {
            XB_SPIN(xb_ld(&bar[XB_XGEN(b.x)]) == gen, bar);
            __builtin_amdgcn_fence(__ATOMIC_ACQUIRE, "agent");
            asm volatile("s_waitcnt vmcnt(0)" ::: "memory");
        }
    }
    __syncthreads();
}

constexpr int NJOBS = 27;
enum { K_PREP = 0, K_ROW = 1, K_GEMM = 2, K_ATTN = 3, K_NONE = 5 };
__host__ __device__ __forceinline__ int job_sync_after(int j) { return !(j == 2 || (j >= 8 && j <= 11) || j == 19 || j == 26); }

__device__ __forceinline__ RowJob make_row(int j, ArgsP ap) {
    unsigned char* ws = ap->ws; const float* mod = (const float*)(ws + WS_MOD); const float* normw = ap->in[3]; float* out = ap->out;
    const int k = (j == 1) ? 0 : (j == 14) ? 1 : (j == 17) ? 2 : (j == 23) ? 3 : 4;
    RowJob r;
    r.xin = (k <= 1) ? ap->in[0] : (const float*)out;
    r.y = (k == 0) ? (const bf16_t*)nullptr : (const bf16_t*)(ws + ((k == 3) ? WS_R1 : WS_R3));
    r.wpost = normw + (2 * k - 1) * 1024;
    r.gate = mod + ((k >= 3) ? 16 * 6144 : 0) + ((k & 1) ? 2 : 5) * 1024;
    r.xout = out;
    r.wpre = normw + (2 * k) * 1024;
    r.sc = mod + ((k >= 2) ? 16 * 6144 : 0) + ((k & 1) ? 4 : 1) * 1024;
    r.sh = mod + ((k >= 2) ? 16 * 6144 : 0) + ((k & 1) ? 3 : 0) * 1024;
    r.hdn = (k == 4) ? (bf16_t*)nullptr : (bf16_t*)(ws + WS_HDN);
    r.mla_tab = 0;
    return r;
}
__device__ __forceinline__ GemmJob make_gemm(int j, unsigned char* ws, bf16_t* outb) {
    GemmJob g{}; g.zdiv = 1; g.nZ = 1;
    bf16_t* HDN = (bf16_t*)(ws + WS_HDN);
    bf16_t* R1 = (bf16_t*)(ws + WS_R1); bf16_t* R2 = (bf16_t*)(ws + WS_R2); bf16_t* R3 = (bf16_t*)(ws + WS_R3);
    if (j == 2) {
        g.A = HDN; g.lda = 1024; g.Bt = (const bf16_t*)(ws + WS_RWIN); g.ldb = 1024; g.K = 1024; g.nM = 128; g.nN = 8; g.epi = EPI_RETQK;
    } else if (j == 3) {
        g.A = (const bf16_t*)(ws + WS_RWIN) + (size_t)2048 * 1024; g.lda = 1024; g.Bt = HDN; g.ldb = 1024; g.K = 1024; g.nM = 8; g.nN = 8; g.nZ = 16; g.zBh = (long)2048 * 1024; g.epi = EPI_STORE; g.var = 0;
    } else if (j >= 4 && j <= 7) {
        const int grp = (j - 4) >> 1;
        if (((j - 4) & 1) == 0) {
            g.A = R1 + (size_t)grp * 8 * 2 * 2048 * 1024; g.lda = 1024; g.zdiv = 4; g.zAh = (long)2 * 2048 * 1024; g.zAl = 256;
            g.Bt = g.A + (size_t)2048 * 1024; g.ldb = 1024; g.zBh = g.zAh; g.zBl = 256;
            g.K = 256; g.nM = 8; g.nN = 8; g.nZ = 32; g.epi = EPI_SDECAY; g.var = grp;
        } else {
            g.A = R3; g.lda = 2048; g.zdiv = 16; g.zAh = (long)(outb - R3); g.zAl = (long)2048 * 2048;
            g.Bt = R2 + (size_t)grp * 8 * 2048 * 2048; g.ldb = 2048; g.zBh = (long)16 * 512 * 2048; g.zBl = (long)512 * 2048;
            g.K = 2048; g.nM = 8; g.nN = 2; g.nZ = 32; g.epi = EPI_OY; g.var = grp * 8;
        }
    } else if (j == 12) {
        g.A = HDN; g.lda = 1024; g.Bt = (const bf16_t*)(ws + WS_RWIN) + (size_t)4096 * 1024; g.ldb = 1024; g.K = 1024; g.nM = 128; g.nN = 8; g.epi = EPI_GATE;
    } else if (j == 13) {
        g.A = R1; g.lda = 2048; g.Bt = (const bf16_t*)(ws + WS_RWOUT); g.ldb = 2048; g.K = 2048; g.nM = 128; g.nN = 4; g.epi = EPI_STORE; g.var = 1;
    } else if (j == 15 || j == 24) {
        const int l = (j == 24);
        g.A = HDN; g.lda = 1024; g.Bt = (const bf16_t*)(ws + WS_W1) + (size_t)l * 4096 * 1024; g.ldb = 1024; g.K = 1024; g.nM = 128; g.nN = 16; g.epi = EPI_RELU2; g.var = 3;
    } else if (j == 16 || j == 25) {
        const int l = (j == 25);
        g.A = R1; g.lda = 4096; g.Bt = (const bf16_t*)(ws + WS_W2) + (size_t)l * 1024 * 4096; g.ldb = 4096; g.K = 4096; g.nM = 128; g.nN = 4; g.epi = EPI_STORE; g.var = 1;
    } else if (j == 18) {
        g.A = HDN; g.lda = 1024; g.Bt = (const bf16_t*)(ws + WS_MWIN); g.ldb = 1024; g.K = 1024; g.nM = 128; g.nN = 3; g.epi = EPI_WIN;
    } else if (j == 19) {
        g.A = R3; g.lda = 768; g.Bt = (const bf16_t*)(ws + WS_MWUQ); g.ldb = 384; g.K = 384; g.nM = 128; g.nN = 6; g.epi = EPI_UQ;
    } else if (j == 20) {
        g.A = R3 + 384; g.lda = 768; g.Bt = (const bf16_t*)(ws + WS_MWUKV); g.ldb = 256; g.K = 256; g.nM = 128; g.nN = 8; g.epi = EPI_UKV;
    } else {
        g.A = (const bf16_t*)(ws + WS_R3 + 64 * MiB); g.lda = 1024; g.Bt = (const bf16_t*)(ws + WS_MWOUT); g.ldb = 1024; g.K = 1024; g.nM = 128; g.nN = 4; g.epi = EPI_STORE; g.var = 2;
    }
    return g;
}

__global__ void __launch_bounds__(512, 2) fwd_megakernel(Args a) {
    extern __shared__ __attribute__((aligned(16))) unsigned char lds_raw[];
    const int G = gridDim.x;
    const int j_lo = a.j_lo, j_hi = a.j_hi;
    volatile LAS unsigned* xb_st = (volatile LAS unsigned*)((LAS unsigned char*)lds_raw + 131072 + 64);
    if (threadIdx.x < 2) xb_st[threadIdx.x] = 0u;
    __syncthreads();
    if (threadIdx.x == 0) (void)xb_add((unsigned*)(a.ws + WS_BAR) + XB_XCNT(xb_xcc_id()), 1u);
#if PROBE
    unsigned long long tprev = __builtin_amdgcn_s_memrealtime(); unsigned tc0 = 0, tc1 = 0, tc2 = 0, tc3 = 0, tc4 = 0, tc5 = 0, tc6 = 0;
#endif
    for (int j = j_lo; j < j_hi; ++j) {
        const int tidl = 0;
        ArgsP ap = (ArgsP)__builtin_amdgcn_kernarg_segment_ptr(); asm volatile("" : "+s"(ap));
        int kind;
        if (j == 0) kind = K_PREP;
        else if (j == 1 || j == 14 || j == 17 || j == 23 || j == 26) kind = K_ROW;
        else if (j == 21) kind = K_ATTN;
        else if (j >= 8 && j <= 11) kind = K_NONE;
        else kind = K_GEMM;
        switch (kind) {
#ifndef NO_PREP
        case K_PREP: prep_phase(ap, (char*)lds_raw, G, tidl); break;
#endif
#ifndef NO_ROW
        case K_ROW: { const RowJob r = make_row(j, ap); row_phase(r, ap, G, tidl); } break;
#endif
#ifndef NO_GEMM
        case K_GEMM: { const GemmJob g = make_gemm(j, ap->ws, (bf16_t*)ap->out); Sched S; S.init(g.nZ, g.nM, g.nN, G, (int)blockIdx.x); gemm_phase((LAS unsigned char*)lds_raw, g, S, ap, tidl); } break;
#endif
#ifndef NO_ATTN
        case K_ATTN: {
            unsigned char* ws = ap->ws;
            const bf16_t* Q1 = (const bf16_t*)(ws + WS_R1); const bf16_t* K1 = Q1 + (size_t)T_TOK * 1536; const bf16_t* V1 = Q1 + (size_t)2 * T_TOK * 1536;
            bf16_t* O = (bf16_t*)(ws + WS_R3 + 64 * MiB);
            const int vcu = (G % 8 == 0) ? ((int)blockIdx.x % 8) * (G / 8) + (int)blockIdx.x / 8 : (int)blockIdx.x;
            for (int un = vcu; un < NB * 8 * 8; un += G) {
                const int bh = un >> 3, qb = un & 7, b = bh >> 3, h = bh & 7;
                const int un2 = un + G; const bool hn = un2 < NB * 8 * 8; const int bh2 = un2 >> 3, b2 = bh2 >> 3, h2 = bh2 & 7;
                mla::attn_unit(Q1 + ((size_t)(b * 2048 + qb * 256) * 1536 + h * 192), K1 + ((size_t)b * 2048 * 1536 + h * 192), V1 + ((size_t)b * 2048 * 1024 + h * 128),
                               O + ((size_t)(b * 2048 + qb * 256) * 1024 + h * 128), (char*)lds_raw, tidl,
                               hn ? K1 + ((size_t)b2 * 2048 * 1536 + h2 * 192) : (const bf16_t*)nullptr, hn ? V1 + ((size_t)b2 * 2048 * 1024 + h2 * 128) : (const bf16_t*)nullptr, un == vcu);
            }
        } break;
#endif
        default: break;
        }
        if (j == 18) mla_table_half(ap, G);
#if PROBE
        __syncthreads(); cg::this_grid().sync();
        { const unsigned long long tn = __builtin_amdgcn_s_memrealtime(); const unsigned dt = (unsigned)(tn - tprev); tprev = tn;
          if (kind == K_PREP) tc0 += dt; else if (kind == K_ROW) tc1 += dt; else if (kind == K_ATTN) tc2 += dt;
          else if (j >= 4 && j <= 11) tc3 += dt; else if (j == 15 || j == 16 || j == 24 || j == 25) tc4 += dt; else tc5 += dt;
          if ((PROBE_MASK >> j) & 1u) tc6 += dt; }
#else
        if (job_sync_after(j) && j + 1 < j_hi) {
            if (j_hi < 0) { __syncthreads(); cg::this_grid().sync(); }
            { XcdBarrier xb; xb.bar = (unsigned*)(ap->ws + WS_BAR); xb.x = xb_xcc_id(); xb.st = xb_st; xcd_barrier(xb); }
        }
        else __syncthreads();
#endif
    }
#if PROBE
    if (blockIdx.x == 0) {
        const unsigned ta = (PROBE == 1) ? tc1 : (PROBE == 2) ? tc2 : (PROBE == 3) ? tc3 : (PROBE == 4) ? tc4 : (PROBE == 5) ? tc5 : (PROBE == 7) ? tc6 : tc0;
        float* out = a.out;
        for (int i = threadIdx.x; i < (1 << 16); i += 512) out[i] += (float)ta * 5.06e-7f;
    }
#endif
}

extern "C" void kernel_launch(void* const* d_in, const int* in_sizes, int n_in, void* d_out, int out_size, void* d_ws, size_t ws_size, hipStream_t stream) {
    static int grid = 0;
    if (grid == 0) {
        if (n_in != 19 || out_size != T_TOK * DM || ws_size < WS_END) { fprintf(stderr, "kernel_launch: unexpected shapes n_in %d out %d ws %zu (need %zu)\n", n_in, out_size, ws_size, (size_t)WS_END); grid = -1; return; }
        int dev = 0, cus = 0, per_cu = 0;
        hipGetDevice(&dev); hipDeviceGetAttribute(&cus, hipDeviceAttributeMultiprocessorCount, dev);
        if (hipFuncSetAttribute((const void*)fwd_megakernel, hipFuncAttributeMaxDynamicSharedMemorySize, LDS_BYTES) != hipSuccess) { fprintf(stderr, "kernel_launch: hipFuncSetAttribute failed\n"); grid = -1; return; }
        if (hipOccupancyMaxActiveBlocksPerMultiprocessor(&per_cu, (const void*)fwd_megakernel, 512, LDS_BYTES) != hipSuccess || per_cu < 1) { fprintf(stderr, "kernel_launch: occupancy query says %d\n", per_cu); per_cu = 1; }
        (void)hipGetLastError();
        grid = cus * 1;
        fprintf(stderr, "kernel_launch: grid %d (cus %d, per_cu %d)\n", grid, cus, per_cu);
    }
    if (grid < 0) return;
    if (hipMemsetAsync((char*)d_ws + WS_MOD, 0, WS_BAR + (size_t)XCD_BAR_WORDS * 4, stream) != hipSuccess) { fprintf(stderr, "kernel_launch: hipMemsetAsync failed\n"); return; }
    Args a{};
    for (int i = 0; i < 19; ++i) a.in[i] = (const float*)d_in[i];
    a.out = (float*)d_out; a.ws = (unsigned char*)d_ws;
#if MULTI_LAUNCH
    int lo = 0;
    for (int j = 0; j < NJOBS; ++j) {
        if (job_sync_after(j) || j == NJOBS - 1) {
            a.j_lo = lo; a.j_hi = j + 1; lo = j + 1;
            hipLaunchKernelGGL(fwd_megakernel, dim3(grid), dim3(512), LDS_BYTES, stream, a);
        }
    }
#else
    a.j_lo = 0; a.j_hi = NJOBS;
    void* args[] = {&a};
    hipError_t e = hipLaunchCooperativeKernel((const void*)fwd_megakernel, dim3(grid), dim3(512), args, LDS_BYTES, stream);
    if (e != hipSuccess) fprintf(stderr, "cooperative launch failed: %s (grid %d)\n", hipGetErrorString(e), grid);
#endif
}
```

```cpp
#include <hip/hip_runtime.h>
#include <hip/hip_cooperative_groups.h>
#include <cstdio>
#include <cstdint>
namespace cg = cooperative_groups;

#ifndef PROBE
#define PROBE 0
#endif
#ifndef PROBE_MASK
#define PROBE_MASK 0x5c0000u
#endif
#ifndef MULTI_LAUNCH
#define MULTI_LAUNCH 0
#endif

#define LAS __attribute__((address_space(3)))
typedef unsigned short bf16_t;
typedef short bf16x8 __attribute__((ext_vector_type(8)));
typedef short s16x4 __attribute__((ext_vector_type(4)));
typedef float f32x4 __attribute__((ext_vector_type(4)));
typedef float f32x2 __attribute__((ext_vector_type(2)));
typedef float f32x16 __attribute__((ext_vector_type(16)));
typedef unsigned u32x4 __attribute__((ext_vector_type(4)));
typedef unsigned u32x2 __attribute__((ext_vector_type(2)));

constexpr int T_TOK = 32768, DM = 1024, NB = 16, SEQ = 2048;
constexpr size_t MiB = 1u << 20;
constexpr size_t WS_MOD = 0;
constexpr size_t WS_BAR = 768 * 1024;
constexpr size_t WS_SSQQ = 1 * MiB;
constexpr size_t WS_SSQKV = 1 * MiB + 256 * 1024;
constexpr size_t WS_DEC = 1 * MiB + 512 * 1024;
constexpr size_t WS_GN = 2 * MiB;
constexpr size_t WS_RWIN = 4 * MiB;
constexpr size_t WS_RWOUT = 16 * MiB;
constexpr size_t WS_MWIN = 20 * MiB;
constexpr size_t WS_MWUQ = 22 * MiB;
constexpr size_t WS_MWUKV = 24 * MiB;
constexpr size_t WS_MWOUT = 25 * MiB;
constexpr size_t WS_W1 = 28 * MiB;
constexpr size_t WS_W2 = 44 * MiB;
constexpr size_t WS_HDN = 60 * MiB;
constexpr size_t WS_R1 = 124 * MiB;
constexpr size_t WS_R2 = 252 * MiB;
constexpr size_t WS_R3 = 380 * MiB;
constexpr size_t WS_END = 508 * MiB;

constexpr int LDS_BYTES = 132096;

struct Args { const float* in[19]; float* out; unsigned char* ws; int j_lo, j_hi; };
typedef const __attribute__((address_space(4))) Args* ArgsP;

__device__ __forceinline__ unsigned cvt_pk_bf16(float lo, float hi) { unsigned r; asm volatile("v_cvt_pk_bf16_f32 %0, %1, %2" : "=v"(r) : "v"(lo), "v"(hi)); return r; }
__device__ __forceinline__ float bf2f(unsigned h) { return __uint_as_float(h << 16); }
__device__ __forceinline__ u32x4 pack8(f32x4 a, f32x4 b) { u32x4 w; w.x = cvt_pk_bf16(a[0], a[1]); w.y = cvt_pk_bf16(a[2], a[3]); w.z = cvt_pk_bf16(b[0], b[1]); w.w = cvt_pk_bf16(b[2], b[3]); return w; }
__device__ __forceinline__ float wave_sum(float v) {
#pragma unroll
    for (int o = 1; o < 64; o <<= 1) v += __shfl_xor(v, o);
    return v;
}
__device__ const float INVF_RET[128] = {1.000000000e+00f, 9.305720329e-01f, 8.659643531e-01f, 8.058421612e-01f, 7.498942018e-01f, 6.978305578e-01f, 6.493816376e-01f, 6.042963862e-01f, 5.623413324e-01f, 5.232990980e-01f, 4.869675338e-01f, 4.531583786e-01f, 4.216965139e-01f, 3.924189806e-01f, 3.651741147e-01f, 3.398208320e-01f, 3.162277639e-01f, 2.942727208e-01f, 2.738419771e-01f, 2.548296750e-01f, 2.371373773e-01f, 2.206734121e-01f, 2.053525001e-01f, 1.910952926e-01f, 1.778279394e-01f, 1.654817164e-01f, 1.539926529e-01f, 1.433012635e-01f, 1.333521456e-01f, 1.240937784e-01f, 1.154781953e-01f, 1.074607819e-01f, 1.000000015e-01f, 9.305720776e-02f, 8.659642935e-02f, 8.058422059e-02f, 7.498942316e-02f, 6.978306174e-02f, 6.493816525e-02f, 6.042964011e-02f, 5.623413250e-02f, 5.232991278e-02f, 4.869675264e-02f, 4.531583562e-02f, 4.216964915e-02f, 3.924189880e-02f, 3.651741147e-02f, 3.398208320e-02f, 3.162277490e-02f, 2.942727134e-02f, 2.738419548e-02f, 2.548296750e-02f, 2.371373773e-02f, 2.206734009e-02f, 2.053525113e-02f, 1.910953037e-02f, 1.778279431e-02f, 1.654817164e-02f, 1.539926510e-02f, 1.433012541e-02f, 1.333521400e-02f, 1.240937784e-02f, 1.154781971e-02f, 1.074607857e-02f, 9.999999776e-03f, 9.305720218e-03f, 8.659643121e-03f, 8.058422245e-03f, 7.498942316e-03f, 6.978305988e-03f, 6.493816152e-03f, 6.042963825e-03f, 5.623413250e-03f, 5.232991185e-03f, 4.869675264e-03f, 4.531583749e-03f, 4.216964822e-03f, 3.924189601e-03f, 3.651741194e-03f, 3.398208413e-03f, 3.162277630e-03f, 2.942727180e-03f, 2.738419687e-03f, 2.548296703e-03f, 2.371373819e-03f, 2.206734149e-03f, 2.053525066e-03f, 1.910952968e-03f, 1.778279431e-03f, 1.654817141e-03f, 1.539926510e-03f, 1.433012541e-03f, 1.333521446e-03f, 1.240937738e-03f, 1.154782018e-03f, 1.074607833e-03f, 1.000000047e-03f, 9.305720450e-04f, 8.659643354e-04f, 8.058421663e-04f, 7.498941850e-04f, 6.978305755e-04f, 6.493816036e-04f, 6.042963942e-04f, 5.623413017e-04f, 5.232990952e-04f, 4.869675322e-04f, 4.531583691e-04f, 4.216965172e-04f, 3.924189659e-04f, 3.651741135e-04f, 3.398208355e-04f, 3.162277571e-04f, 2.942727297e-04f, 2.738419571e-04f, 2.548296761e-04f, 2.371373703e-04f, 2.206734061e-04f, 2.053525095e-04f, 1.910952997e-04f, 1.778279402e-04f, 1.654817170e-04f, 1.539926598e-04f, 1.433012512e-04f, 1.333521504e-04f, 1.240937709e-04f, 1.154782003e-04f, 1.074607862e-04f};
__device__ const float INVF_MLA[32] = {1.000000000e+00f, 7.498942018e-01f, 5.623413324e-01f, 4.216965139e-01f, 3.162277639e-01f, 2.371373773e-01f, 1.778279394e-01f, 1.333521456e-01f, 1.000000015e-01f, 7.498942316e-02f, 5.623413250e-02f, 4.216964915e-02f, 3.162277490e-02f, 2.371373773e-02f, 1.778279431e-02f, 1.333521400e-02f, 9.999999776e-03f, 7.498942316e-03f, 5.623413250e-03f, 4.216964822e-03f, 3.162277630e-03f, 2.371373819e-03f, 1.778279431e-03f, 1.333521446e-03f, 1.000000047e-03f, 7.498941850e-04f, 5.623413017e-04f, 4.216965172e-04f, 3.162277571e-04f, 2.371373703e-04f, 1.778279402e-04f, 1.333521504e-04f};
__device__ __forceinline__ void sincos_f(float x, float& s, float& c) {
    const float n = rintf(x * 0.636619772f);
    float r = fmaf(-n, 1.57079637050628662109375f, x); r = fmaf(-n, -4.37113900018624283e-8f, r); r = fmaf(-n, -1.7151245100059e-15f, r);
    const int q = ((int)n) & 3; const float r2 = r * r;
    const float sp = fmaf(fmaf(fmaf(-1.9515295891e-4f, r2, 8.3321608736e-3f), r2, -1.6666654611e-1f) * r2, r, r);
    const float cp = fmaf(fmaf(fmaf(2.443315711809948e-5f, r2, -1.388731625493765e-3f), r2, 4.166664568298827e-2f), r2 * r2, fmaf(-0.5f, r2, 1.0f));
    s = (q == 0) ? sp : (q == 1) ? cp : (q == 2) ? -sp : -cp;
    c = (q == 0) ? cp : (q == 1) ? -sp : (q == 2) ? -cp : sp;
}

constexpr int BM = 256, BK = 64, HALF = 128, HTB = HALF * BK * 2, NXCD = 8, WGM = 8;
__device__ __forceinline__ int lds_byte(int r, int c) { const int st = (r >> 4) * 2 + (c >> 5), rr = r & 15, cc = c & 31, ob = rr * 64 + cc * 2; return st * 1024 + (ob ^ (((ob >> 9) & 1) << 5)); }
__device__ __forceinline__ void stage_rc(int b, int& R, int& C) { const int st = b / 1024, sb = b % 1024, swz = sb ^ (((sb >> 9) & 1) << 5); R = (st >> 1) * 16 + swz / 64; C = (st & 1) * 32 + (swz % 64) / 2; }
__device__ __forceinline__ int perm32(int rho) { const int n = rho >> 4, i = rho & 15; return 8 * (i >> 2) + 4 * n + (i & 3); }

struct Unit { int z, pm, pn; };
enum { EPI_RETQK = 0, EPI_STORE = 1, EPI_RELU2 = 2, EPI_SDECAY = 3, EPI_OY = 4, EPI_GATE = 5, EPI_WIN = 6, EPI_UQ = 7, EPI_UKV = 8 };
struct GemmJob {
    const bf16_t* A; const bf16_t* Bt; int lda, ldb, K, nM, nN, nZ;
    long zAh, zAl, zBh, zBl; int zdiv;
    int epi; int var;
    int rev;
};
struct EpiPtr { bf16_t* out; bf16_t* out2; int ldc; long zC; const float* f0; const float* f1; float* s0; float* s1; const bf16_t* b0; };
struct Sched {
    int nM, nN, nwg, per, G, c, rev;
    __device__ __forceinline__ void init(int nZ, int nM_, int nN_, int G_, int c_, int rev_ = 0) { nM = nM_; nN = nN_; per = nM * nN; nwg = nZ * per; G = G_; c = c_; rev = rev_; }
    __device__ __forceinline__ bool next(int i, Unit& u) const {
        const long L = (long)i * G + c; if (L >= nwg) return false;
        int wgid = (int)L; { const int q = nwg / NXCD, r = nwg % NXCD, xcd = wgid % NXCD; int off = wgid / NXCD; if (rev && r == 0) off = q - 1 - off; wgid = (xcd < r ? xcd * (q + 1) : r * (q + 1) + (xcd - r) * q) + off; }
        u.z = wgid / per; const int w = wgid % per;
        const int nig = WGM * nN, gid = w / nig, fm = gid * WGM, gsz = (nM - fm) < WGM ? (nM - fm) : WGM;
        u.pm = fm + ((w % nig) % gsz); u.pn = (w % nig) / gsz; return true;
    }
};

typedef f32x4 Acc[2][2][4][2];

#ifndef EPI_MASK
#define EPI_MASK 0x1ff
#endif
#define EPI_FENCE() asm volatile("" ::: "memory")
__device__ __forceinline__ void epilogue(const Acc& acc, const Unit& u, int wr, int wc, int fr_in, int fq_in, const int epi, const int var, ArgsP ap) {
    unsigned char* ws = ap->ws;
    int fr = fr_in, fq = fq_in; asm volatile("" : "+v"(fr), "+v"(fq));
    const int rowb = u.pm * BM + wr * 64 + fr;
    const int colb = wc * 32 + 8 * fq;
    EpiPtr J{};
    switch (epi) {
    case EPI_RETQK: { if (!((EPI_MASK >> EPI_RETQK) & 1)) break;
        J.out = (bf16_t*)(ws + WS_R1); J.f0 = (const float*)(ws + WS_R3);
        const int kpart = u.pn >> 2, h = u.pn & 3; const float sc = kpart ? 0.0625f : 1.0f;
#pragma unroll
        for (int ai = 0; ai < 2; ++ai) {
            f32x4 tb[4][4];
#pragma unroll
            for (int m = 0; m < 4; ++m) {
                const int row = rowb + ai * HALF + m * 16;
                const f32x4* tp = (const f32x4*)(J.f0 + ((size_t)row * 128 + colb) * 2);
                tb[m][0] = tp[0]; tb[m][1] = tp[1]; tb[m][2] = tp[2]; tb[m][3] = tp[3];
            }
#pragma unroll
            for (int m = 0; m < 4; ++m) {
                const int row = rowb + ai * HALF + m * 16; const int b = row >> 11, s = row & 2047;
                bf16_t* dst = J.out + ((size_t)(b * 2 + kpart) * 2048 + s) * 1024 + h * 256 + colb;
                const f32x4 t0 = tb[m][0], t1 = tb[m][1], t2 = tb[m][2], t3 = tb[m][3];
                const f32x4 a0 = acc[ai][0][m][0], a1 = acc[ai][0][m][1], b0 = acc[ai][1][m][0], b1 = acc[ai][1][m][1];
                f32x4 o0, o1, p0, p1;
                o0[0] = (a0[0] * t0[0] - b0[0] * t0[1]) * sc; p0[0] = (a0[0] * t0[1] + b0[0] * t0[0]) * sc;
                o0[1] = (a0[1] * t0[2] - b0[1] * t0[3]) * sc; p0[1] = (a0[1] * t0[3] + b0[1] * t0[2]) * sc;
                o0[2] = (a0[2] * t1[0] - b0[2] * t1[1]) * sc; p0[2] = (a0[2] * t1[1] + b0[2] * t1[0]) * sc;
                o0[3] = (a0[3] * t1[2] - b0[3] * t1[3]) * sc; p0[3] = (a0[3] * t1[3] + b0[3] * t1[2]) * sc;
                o1[0] = (a1[0] * t2[0] - b1[0] * t2[1]) * sc; p1[0] = (a1[0] * t2[1] + b1[0] * t2[0]) * sc;
                o1[1] = (a1[1] * t2[2] - b1[1] * t2[3]) * sc; p1[1] = (a1[1] * t2[3] + b1[1] * t2[2]) * sc;
                o1[2] = (a1[2] * t3[0] - b1[2] * t3[1]) * sc; p1[2] = (a1[2] * t3[1] + b1[2] * t3[0]) * sc;
                o1[3] = (a1[3] * t3[2] - b1[3] * t3[3]) * sc; p1[3] = (a1[3] * t3[3] + b1[3] * t3[2]) * sc;
                *(u32x4*)dst = pack8(o0, o1); *(u32x4*)(dst + 128) = pack8(p0, p1);
            }
            EPI_FENCE();
        }
    } break;
    case EPI_STORE: case EPI_RELU2: { if (!((EPI_MASK >> EPI_STORE) & 1)) break;
        if (var == 0) { J.out = (bf16_t*)(ws + WS_R2); J.ldc = 2048; J.zC = (long)2048 * 2048; } else if (var == 1) { J.out = (bf16_t*)(ws + WS_R3); J.ldc = 1024; } else if (var == 2) { J.out = (bf16_t*)(ws + WS_R1); J.ldc = 1024; } else { J.out = (bf16_t*)(ws + WS_R1); J.ldc = 4096; }
        bf16_t* base = J.out + (size_t)(u.z & 15) * J.zC + u.pn * BM + colb;
#pragma unroll
        for (int ai = 0; ai < 2; ++ai)
#pragma unroll
            for (int m = 0; m < 4; ++m) {
                bf16_t* rowp = base + (size_t)(rowb + ai * HALF + m * 16) * J.ldc;
#pragma unroll
                for (int bj = 0; bj < 2; ++bj) {
                    f32x4 v0 = acc[ai][bj][m][0], v1 = acc[ai][bj][m][1];
                    if (epi == EPI_RELU2) {
#pragma unroll
                        for (int i = 0; i < 4; ++i) { const float x0 = fmaxf(v0[i], 0.f), x1 = fmaxf(v1[i], 0.f); v0[i] = x0 * x0; v1[i] = x1 * x1; }
                    }
                    if (epi == EPI_RELU2) __builtin_nontemporal_store(pack8(v0, v1), (u32x4*)(rowp + bj * HALF));
                    else *(u32x4*)(rowp + bj * HALF) = pack8(v0, v1);
                }
            }
    } break;
    case EPI_SDECAY: { if (!((EPI_MASK >> EPI_SDECAY) & 1)) break;
        J.out = (u.z >= 16) ? (bf16_t*)ap->out : (bf16_t*)(ws + WS_R3); J.ldc = 2048; J.zC = (long)2048 * 2048; J.f0 = (const float*)(ws + WS_DEC);
        const int h = u.z & 3;
        const float lf = J.f0[h], lb = J.f0[4 + h];
        bf16_t* base = J.out + (size_t)(u.z & 15) * J.zC + u.pn * BM + colb;
        if (u.pm == u.pn) {
#pragma unroll
            for (int ai = 0; ai < 2; ++ai)
#pragma unroll
                for (int m = 0; m < 4; ++m) {
                    const int row = rowb + ai * HALF + m * 16;
                    bf16_t* rowp = base + (size_t)row * J.ldc;
#pragma unroll
                    for (int bj = 0; bj < 2; ++bj) {
                        const int col = u.pn * BM + bj * HALF + colb;
                        f32x4 v0 = acc[ai][bj][m][0], v1 = acc[ai][bj][m][1];
#pragma unroll
                        for (int i = 0; i < 4; ++i) {
                            const int d0 = row - (col + i), d1 = row - (col + 4 + i);
                            v0[i] *= __builtin_amdgcn_exp2f(d0 >= 0 ? lf * (float)d0 : lb * (float)(-d0));
                            v1[i] *= __builtin_amdgcn_exp2f(d1 >= 0 ? lf * (float)d1 : lb * (float)(-d1));
                        }
                        *(u32x4*)(rowp + bj * HALF) = pack8(v0, v1);
                    }
                }
        } else {
            const bool below = u.pm > u.pn; const int R0 = u.pm * BM, C0 = u.pn * BM; const float lg = below ? lf : lb;
            f32x4 cf[2][2];
#pragma unroll
            for (int bj = 0; bj < 2; ++bj)
#pragma unroll
                for (int n = 0; n < 2; ++n)
#pragma unroll
                    for (int i = 0; i < 4; ++i) { const int col = C0 + bj * HALF + colb + 4 * n + i; cf[bj][n][i] = __builtin_amdgcn_exp2f(lg * (float)(below ? (R0 - col) : (col - C0))); }
#pragma unroll
            for (int ai = 0; ai < 2; ++ai)
#pragma unroll
                for (int m = 0; m < 4; ++m) {
                    const int row = rowb + ai * HALF + m * 16;
                    const float rf = __builtin_amdgcn_exp2f(lg * (float)(below ? (row - R0) : (C0 - row)));
                    bf16_t* rowp = base + (size_t)row * J.ldc;
#pragma unroll
                    for (int bj = 0; bj < 2; ++bj)
                        *(u32x4*)(rowp + bj * HALF) = pack8(acc[ai][bj][m][0] * (cf[bj][0] * rf), acc[ai][bj][m][1] * (cf[bj][1] * rf));
                }
        }
    } break;
    case EPI_OY: { if (!((EPI_MASK >> EPI_OY) & 1)) break;
        J.out = (bf16_t*)(ws + WS_R1); J.s0 = (float*)(ws + WS_GN);
        const int b = var + (u.z >> 2), h = u.z & 3;
#pragma unroll
        for (int ai = 0; ai < 2; ++ai)
#pragma unroll
            for (int m = 0; m < 4; ++m) {
                const int row = rowb + ai * HALF + m * 16; const size_t tok = (size_t)b * 2048 + row;
                bf16_t* rowp = J.out + tok * 2048 + h * 512 + u.pn * BM + colb;
                float s1 = 0.f, s2 = 0.f;
#pragma unroll
                for (int bj = 0; bj < 2; ++bj) {
                    const f32x4 v0 = acc[ai][bj][m][0], v1 = acc[ai][bj][m][1];
#pragma unroll
                    for (int i = 0; i < 4; ++i) { s1 += v0[i] + v1[i]; s2 += v0[i] * v0[i] + v1[i] * v1[i]; }
                    *(u32x4*)(rowp + bj * HALF) = pack8(v0, v1);
                }
                s1 += __shfl_xor(s1, 16); s1 += __shfl_xor(s1, 32); s2 += __shfl_xor(s2, 16); s2 += __shfl_xor(s2, 32);
                if (fq == 0) { float* g = J.s0 + (tok * 4 + h) * 2; atomicAdd(g, s1); atomicAdd(g + 1, s2); }
                EPI_FENCE();
            }
    } break;
    case EPI_GATE: { if (!((EPI_MASK >> EPI_GATE) & 1)) break;
        J.out = (bf16_t*)(ws + WS_R1); J.f0 = (const float*)(ws + WS_GN); J.f1 = ap->in[9];
        const int h = u.pn >> 1;
        f32x4 gw[2][2];
#pragma unroll
        for (int bj = 0; bj < 2; ++bj)
#pragma unroll
            for (int n = 0; n < 2; ++n) gw[bj][n] = *(const f32x4*)(J.f1 + u.pn * BM + bj * HALF + colb + 4 * n);
#pragma unroll
        for (int ai = 0; ai < 2; ++ai) {
            f32x2 st[4]; u32x4 yv[4][2];
#pragma unroll
            for (int m = 0; m < 4; ++m) {
                const size_t tok = (size_t)(rowb + ai * HALF + m * 16);
                st[m] = *(const f32x2*)(J.f0 + (tok * 4 + h) * 2);
                const bf16_t* rowp = J.out + tok * 2048 + u.pn * BM + colb;
                yv[m][0] = *(const u32x4*)(rowp); yv[m][1] = *(const u32x4*)(rowp + HALF);
            }
#pragma unroll
            for (int m = 0; m < 4; ++m) {
                const size_t tok = (size_t)(rowb + ai * HALF + m * 16);
                const float mu = st[m][0] * (1.0f / 512.0f); const float var = st[m][1] * (1.0f / 512.0f) - mu * mu;
                const float rstd = 1.0f / sqrtf(fmaxf(var, 0.f) + 1e-5f);
                bf16_t* rowp = J.out + tok * 2048 + u.pn * BM + colb;
#pragma unroll
                for (int bj = 0; bj < 2; ++bj) {
                    const u32x4 yw = yv[m][bj];
                    const f32x4 a0 = acc[ai][bj][m][0], a1 = acc[ai][bj][m][1];
                    f32x4 y0, y1, o0, o1;
                    y0[0] = bf2f(yw.x & 0xffffu); y0[1] = bf2f(yw.x >> 16); y0[2] = bf2f(yw.y & 0xffffu); y0[3] = bf2f(yw.y >> 16);
                    y1[0] = bf2f(yw.z & 0xffffu); y1[1] = bf2f(yw.z >> 16); y1[2] = bf2f(yw.w & 0xffffu); y1[3] = bf2f(yw.w >> 16);
#pragma unroll
                    for (int i = 0; i < 4; ++i) {
                        const float sg0 = a0[i] * __builtin_amdgcn_rcpf(1.0f + __expf(-a0[i])), sg1 = a1[i] * __builtin_amdgcn_rcpf(1.0f + __expf(-a1[i]));
                        o0[i] = sg0 * ((y0[i] - mu) * rstd * gw[bj][0][i]); o1[i] = sg1 * ((y1[i] - mu) * rstd * gw[bj][1][i]);
                    }
                    *(u32x4*)(rowp + bj * HALF) = pack8(o0, o1);
                }
            }
            EPI_FENCE();
        }
    } break;
    case EPI_WIN: { if (!((EPI_MASK >> EPI_WIN) & 1)) break;
        J.out = (bf16_t*)(ws + WS_R3); J.s0 = (float*)(ws + WS_SSQQ); J.s1 = (float*)(ws + WS_SSQKV);
#pragma unroll
        for (int ai = 0; ai < 2; ++ai)
#pragma unroll
            for (int m = 0; m < 4; ++m) {
                const int row = rowb + ai * HALF + m * 16;
                bf16_t* rowp = J.out + (size_t)row * 768 + u.pn * BM + colb;
                float sq = 0.f, skv = 0.f;
#pragma unroll
                for (int bj = 0; bj < 2; ++bj) {
                    const f32x4 v0 = acc[ai][bj][m][0], v1 = acc[ai][bj][m][1];
                    float s = 0.f;
#pragma unroll
                    for (int i = 0; i < 4; ++i) s += v0[i] * v0[i] + v1[i] * v1[i];
                    const int reg = u.pn * 2 + bj;
                    if (reg < 3) sq += s; else if (reg < 5) skv += s;
                    *(u32x4*)(rowp + bj * HALF) = pack8(v0, v1);
                }
                sq += __shfl_xor(sq, 16); sq += __shfl_xor(sq, 32); skv += __shfl_xor(skv, 16); skv += __shfl_xor(skv, 32);
                if (fq == 0) { if (u.pn < 2) atomicAdd(J.s0 + row, sq); if (u.pn > 0) atomicAdd(J.s1 + row, skv); }
                EPI_FENCE();
            }
    } break;
    case EPI_UQ: { if (!((EPI_MASK >> EPI_UQ) & 1)) break;
        J.out = (bf16_t*)(ws + WS_R1); J.f0 = (const float*)(ws + WS_SSQQ); J.f1 = (const float*)(ws + WS_R3 + 64 * MiB);
#pragma unroll
        for (int ai = 0; ai < 2; ++ai)
#pragma unroll
            for (int m = 0; m < 4; ++m) {
                const int row = rowb + ai * HALF + m * 16;
                const float rstd = 1.0f / sqrtf(J.f0[row] * (1.0f / 384.0f) + 1e-6f);
                bf16_t* qrow = J.out + (size_t)row * 1536;
                if (u.pn < 4) {
#pragma unroll
                    for (int bj = 0; bj < 2; ++bj) {
                        const int hd = u.pn * 2 + bj;
                        *(u32x4*)(qrow + hd * 192 + colb) = pack8(acc[ai][bj][m][0] * rstd, acc[ai][bj][m][1] * rstd);
                    }
                } else {
                    const int hd = (u.pn - 4) * 4 + wc; const int j0 = 8 * fq;
                    const f32x4* tp = (const f32x4*)(J.f1 + ((size_t)row * 32 + j0) * 2);
                    const f32x4 t0 = tp[0], t1 = tp[1], t2 = tp[2], t3 = tp[3];
                    const f32x4 a0 = acc[ai][0][m][0] * rstd, a1 = acc[ai][0][m][1] * rstd, b0 = acc[ai][1][m][0] * rstd, b1 = acc[ai][1][m][1] * rstd;
                    f32x4 o0, o1, p0, p1;
                    o0[0] = a0[0] * t0[0] - b0[0] * t0[1]; p0[0] = a0[0] * t0[1] + b0[0] * t0[0];
                    o0[1] = a0[1] * t0[2] - b0[1] * t0[3]; p0[1] = a0[1] * t0[3] + b0[1] * t0[2];
                    o0[2] = a0[2] * t1[0] - b0[2] * t1[1]; p0[2] = a0[2] * t1[1] + b0[2] * t1[0];
                    o0[3] = a0[3] * t1[2] - b0[3] * t1[3]; p0[3] = a0[3] * t1[3] + b0[3] * t1[2];
                    o1[0] = a1[0] * t2[0] - b1[0] * t2[1]; p1[0] = a1[0] * t2[1] + b1[0] * t2[0];
                    o1[1] = a1[1] * t2[2] - b1[1] * t2[3]; p1[1] = a1[1] * t2[3] + b1[1] * t2[2];
                    o1[2] = a1[2] * t3[0] - b1[2] * t3[1]; p1[2] = a1[2] * t3[1] + b1[2] * t3[0];
                    o1[3] = a1[3] * t3[2] - b1[3] * t3[3]; p1[3] = a1[3] * t3[3] + b1[3] * t3[2];
                    *(u32x4*)(qrow + hd * 192 + 128 + j0) = pack8(o0, o1); *(u32x4*)(qrow + hd * 192 + 160 + j0) = pack8(p0, p1);
                }
                EPI_FENCE();
            }
    } break;
    case EPI_UKV: { if (!((EPI_MASK >> EPI_UKV) & 1)) break;
        J.out = (bf16_t*)(ws + WS_R1) + (size_t)T_TOK * 1536; J.out2 = (bf16_t*)(ws + WS_R1) + (size_t)2 * T_TOK * 1536; J.f0 = (const float*)(ws + WS_SSQKV); J.f1 = (const float*)(ws + WS_R3 + 64 * MiB); J.b0 = (bf16_t*)(ws + WS_R3);
        const int hd = u.pn;
#pragma unroll
        for (int ai = 0; ai < 2; ++ai)
#pragma unroll
            for (int m = 0; m < 4; ++m) {
                const int row = rowb + ai * HALF + m * 16;
                const float rstd = 1.0f / sqrtf(J.f0[row] * (1.0f / 256.0f) + 1e-6f);
                bf16_t* krow = J.out + (size_t)row * 1536 + hd * 192;
                *(u32x4*)(krow + colb) = pack8(acc[ai][0][m][0] * rstd, acc[ai][0][m][1] * rstd);
                *(u32x4*)(J.out2 + (size_t)row * 1024 + hd * 128 + colb) = pack8(acc[ai][1][m][0] * rstd, acc[ai][1][m][1] * rstd);
                const int j = wc * 8 + fq * 2;
                const unsigned c1 = *(const unsigned*)(J.b0 + (size_t)row * 768 + 640 + j), c2 = *(const unsigned*)(J.b0 + (size_t)row * 768 + 672 + j);
                const f32x4 t = *(const f32x4*)(J.f1 + ((size_t)row * 32 + j) * 2);
                const float x0 = bf2f(c1 & 0xffffu), x1 = bf2f(c1 >> 16), y0 = bf2f(c2 & 0xffffu), y1 = bf2f(c2 >> 16);
                *(unsigned*)(krow + 128 + j) = cvt_pk_bf16(x0 * t[0] - y0 * t[1], x1 * t[2] - y1 * t[3]);
                *(unsigned*)(krow + 160 + j) = cvt_pk_bf16(x0 * t[1] + y0 * t[0], x1 * t[3] + y1 * t[2]);
                EPI_FENCE();
            }
    } break;
    default: break;
    }
}

__device__ __forceinline__ void gemm_phase(LAS unsigned char* lds, const GemmJob& g, const Sched& S, ArgsP ap, const int tid_in) {
    int tid = threadIdx.x; asm volatile("" : "+v"(tid)); (void)tid_in;
    const int wid = __builtin_amdgcn_readfirstlane(tid >> 6), lane = tid & 63, wr = wid >> 2, wc = wid & 3, fr = lane & 15, fq = lane >> 4;
    const int nt = g.K / BK;
    unsigned voffA[2], voffB[2];
#pragma unroll
    for (int i = 0; i < 2; ++i) { int R, C; stage_rc(tid * 16 + i * 8192, R, C); const int Rb = (R & ~31) + perm32(R & 31);
        voffA[i] = (unsigned)(R * g.lda + C) * 2u; voffB[i] = (unsigned)(Rb * g.ldb + C) * 2u; }
    const size_t kstep = (size_t)(BK * 2);
    const size_t hstepA = (size_t)HALF * g.lda * 2, hstepB = (size_t)HALF * g.ldb * 2;
    const unsigned ldsw = (unsigned)wid * 1024u;
    const int aoff = lds_byte(wr * 64 + fr, fq * 8), boff = lds_byte(wc * 32 + fr, fq * 8);
#define PG8_SA(b, h) (((b) * 2 + (h)) * HTB)
#define PG8_SB(b, h) ((4 + (b) * 2 + (h)) * HTB)
#define PG8_STAGE(bufoff, gbase, voff) do { _Pragma("unroll") for (int _i = 0; _i < 2; ++_i) \
        __builtin_amdgcn_global_load_lds((const unsigned*)((const char*)(gbase) + (voff)[_i]), (LAS unsigned*)(lds + (bufoff) + ldsw + _i * 8192), 16, 0, 0); } while (0)
#define PG8_LDA(dst, b, h) do { _Pragma("unroll") for (int m = 0; m < 4; ++m) _Pragma("unroll") for (int k = 0; k < 2; ++k) dst[m][k] = *(const LAS bf16x8*)(lds + PG8_SA(b, h) + aoff + m * 2048 + k * 1024); } while (0)
#define PG8_LDB(dst, b, h) do { _Pragma("unroll") for (int n = 0; n < 2; ++n) _Pragma("unroll") for (int k = 0; k < 2; ++k) dst[n][k] = *(const LAS bf16x8*)(lds + PG8_SB(b, h) + boff + n * 2048 + k * 1024); } while (0)
#define PG8_MMA(ai, bj, At, Bt) do { __builtin_amdgcn_s_setprio(1); _Pragma("unroll") for (int m = 0; m < 4; ++m) _Pragma("unroll") for (int n = 0; n < 2; ++n) _Pragma("unroll") for (int k = 0; k < 2; ++k) \
        acc[ai][bj][m][n] = __builtin_amdgcn_mfma_f32_16x16x32_bf16(Bt[n][k], At[m][k], acc[ai][bj][m][n], 0, 0, 0); __builtin_amdgcn_s_setprio(0); } while (0)
#define PG8_WAIT_V(n) asm volatile("s_waitcnt vmcnt(" #n ")" ::: "memory")
#define PG8_WAIT_L(n) asm volatile("s_waitcnt lgkmcnt(" #n ")" ::: "memory")
#define PG8_BAR __builtin_amdgcn_s_barrier()
#define PG8_SCHED __builtin_amdgcn_sched_barrier(0)
#define PG8_PTRA(u) ((const char*)g.A + 2 * ((size_t)((u).z / g.zdiv) * g.zAh + (size_t)((u).z % g.zdiv) * g.zAl + (size_t)(u).pm * BM * g.lda))
#define PG8_PTRB(u) ((const char*)g.Bt + 2 * ((size_t)((u).z / g.zdiv) * g.zBh + (size_t)((u).z % g.zdiv) * g.zBl + (size_t)(u).pn * BM * g.ldb))
    Unit cur, nxt; int ui = 0;
    if (!S.next(0, cur)) return;
    Acc acc;
#pragma unroll
    for (int a = 0; a < 2; ++a)
#pragma unroll
        for (int b = 0; b < 2; ++b)
#pragma unroll
            for (int m = 0; m < 4; ++m)
#pragma unroll
                for (int n = 0; n < 2; ++n) acc[a][b][m][n] = (f32x4){0.f, 0.f, 0.f, 0.f};
    bf16x8 At[4][2], B0[2][2], B1[2][2];
    const char* cA = PG8_PTRA(cur); const char* cB = PG8_PTRB(cur);
    PG8_STAGE(PG8_SB(0, 0), cB, voffB); PG8_STAGE(PG8_SB(0, 1), cB + hstepB, voffB); PG8_STAGE(PG8_SA(0, 0), cA, voffA); PG8_STAGE(PG8_SA(0, 1), cA + hstepA, voffA);
    if (wr == 1) PG8_BAR;
    PG8_WAIT_V(2); PG8_BAR;
    PG8_STAGE(PG8_SB(1, 0), cB + kstep, voffB); PG8_STAGE(PG8_SA(1, 0), cA + kstep, voffA); PG8_STAGE(PG8_SB(1, 1), cB + hstepB + kstep, voffB);
    PG8_WAIT_V(6); PG8_BAR;
    for (;;) {
        const bool has_next = S.next(ui + 1, nxt);
        const char* nA = cA; const char* nB = cB;
        if (has_next) { nA = PG8_PTRA(nxt); nB = PG8_PTRB(nxt); }
        for (int t = 0; t < nt; t += 2) {
            const bool last = (t == nt - 2);
            const char* a1 = cA + (size_t)(t + 1) * kstep;
            const char* a2 = last ? nA : cA + (size_t)(t + 2) * kstep; const char* b2 = last ? nB : cB + (size_t)(t + 2) * kstep;
            const char* a3 = a2 + kstep; const char* b3 = b2 + kstep;
            PG8_LDB(B0, 0, 0); PG8_LDB(B1, 0, 1); PG8_SCHED; PG8_LDA(At, 0, 0); PG8_STAGE(PG8_SA(1, 1), a1 + hstepA, voffA);
            PG8_WAIT_V(8); PG8_WAIT_L(0); PG8_BAR; PG8_MMA(0, 0, At, B0); PG8_MMA(0, 1, At, B1); PG8_BAR; PG8_SCHED;
            PG8_LDA(At, 0, 1); PG8_STAGE(PG8_SB(0, 0), b2, voffB); PG8_STAGE(PG8_SB(0, 1), b2 + hstepB, voffB); PG8_STAGE(PG8_SA(0, 0), a2, voffA);
            PG8_WAIT_V(8); PG8_WAIT_L(0); PG8_BAR; PG8_MMA(1, 0, At, B0); PG8_MMA(1, 1, At, B1); PG8_BAR; PG8_SCHED;
            PG8_LDB(B0, 1, 0); PG8_LDB(B1, 1, 1); PG8_SCHED; PG8_LDA(At, 1, 0); PG8_STAGE(PG8_SA(0, 1), a2 + hstepA, voffA);
            PG8_WAIT_V(8); PG8_WAIT_L(0); PG8_BAR; PG8_MMA(0, 0, At, B0); PG8_MMA(0, 1, At, B1); PG8_BAR; PG8_SCHED;
            PG8_LDA(At, 1, 1); PG8_STAGE(PG8_SB(1, 0), b3, voffB); PG8_STAGE(PG8_SB(1, 1), b3 + hstepB, voffB); PG8_STAGE(PG8_SA(1, 0), a3, voffA);
            PG8_WAIT_V(8); PG8_WAIT_L(0); PG8_BAR; PG8_MMA(1, 0, At, B0); PG8_MMA(1, 1, At, B1); PG8_BAR; PG8_SCHED;
        }
        if (wr == 0) PG8_BAR;
        epilogue(acc, cur, wr, wc, fr, fq, g.epi, g.var, ap);
        if (!has_next) break;
#pragma unroll
        for (int a = 0; a < 2; ++a)
#pragma unroll
            for (int b = 0; b < 2; ++b)
#pragma unroll
                for (int m = 0; m < 4; ++m)
#pragma unroll
                    for (int n = 0; n < 2; ++n) acc[a][b][m][n] = (f32x4){0.f, 0.f, 0.f, 0.f};
        cur = nxt; cA = nA; cB = nB; ++ui;
        if (wr == 1) PG8_BAR;
    }
    PG8_WAIT_V(0);
    PG8_BAR;
#undef PG8_SA
#undef PG8_SB
#undef PG8_STAGE
#undef PG8_LDA
#undef PG8_LDB
#undef PG8_MMA
#undef PG8_WAIT_V
#undef PG8_WAIT_L
#undef PG8_BAR
#undef PG8_SCHED
#undef PG8_PTRA
#undef PG8_PTRB
}

namespace mla {
constexpr int LDQ = 1536, LDK = 1536, LDV = 1024, LDO = 1024;
constexpr int KT_BYTES = 64 * 192 * 2, VT_BYTES = 64 * 128 * 2;
constexpr int V_OFF = 0, K_OFF = 2 * VT_BYTES, WS_OFF = K_OFF + 2 * KT_BYTES;
constexpr float SCALE = 0.07216878364870322f;
constexpr float THR = 8.f;
#define KSWZ(row, colB) ((row) * 384 + ((colB) ^ (((row) & 7) << 4)))
#define SBAR() __builtin_amdgcn_sched_barrier(0)
__device__ __forceinline__ int crow(int r, int hi) { return (r & 3) + 8 * (r >> 2) + 4 * hi; }
__device__ __forceinline__ void partialSM(f32x16& p0, f32x16& p1, float& m_reg, float& mn, float& alpha) {
    constexpr float C = SCALE * 1.4426950408889634f;
    float pmax = p0[0];
#pragma unroll
    for (int r = 1; r < 16; ++r) pmax = fmaxf(pmax, p0[r]);
#pragma unroll
    for (int r = 0; r < 16; ++r) pmax = fmaxf(pmax, p1[r]);
    { auto rr = __builtin_amdgcn_permlane32_swap(__float_as_uint(pmax), __float_as_uint(pmax), false, false);
      pmax = fmaxf(__uint_as_float(rr[0]), __uint_as_float(rr[1])); }
    if (__builtin_expect(__all(pmax - m_reg <= THR / SCALE), 1)) { mn = m_reg; alpha = 1.f; }
    else { mn = fmaxf(m_reg, pmax); alpha = __builtin_amdgcn_exp2f((m_reg - mn) * C); m_reg = mn; }
    const float mnC = -mn * C;
#pragma unroll
    for (int r = 0; r < 16; ++r) p0[r] = __builtin_amdgcn_exp2f(fmaf(p0[r], C, mnC));
#pragma unroll
    for (int r = 0; r < 16; ++r) p1[r] = __builtin_amdgcn_exp2f(fmaf(p1[r], C, mnC));
}
__device__ __forceinline__ void finishSM(f32x16& p0, f32x16& p1, float alpha, float& l_reg, bf16x8& pa0, bf16x8& pa1, bf16x8& pa2, bf16x8& pa3) {
    float ps = 0;
#pragma unroll
    for (int r = 0; r < 16; ++r) ps += p0[r];
#pragma unroll
    for (int r = 0; r < 16; ++r) ps += p1[r];
    { auto rr = __builtin_amdgcn_permlane32_swap(__float_as_uint(ps), __float_as_uint(ps), false, false);
      ps = __uint_as_float(rr[0]) + __uint_as_float(rr[1]); }
    l_reg = l_reg * alpha + ps;
#define PK4(P, BASE, OUT) do { unsigned a0 = cvt_pk_bf16(P[BASE + 0], P[BASE + 1]), a1 = cvt_pk_bf16(P[BASE + 2], P[BASE + 3]);   \
    unsigned b0 = cvt_pk_bf16(P[BASE + 4], P[BASE + 5]), b1 = cvt_pk_bf16(P[BASE + 6], P[BASE + 7]);                              \
    auto r0 = __builtin_amdgcn_permlane32_swap(a0, b0, false, false); auto r1 = __builtin_amdgcn_permlane32_swap(a1, b1, false, false); \
    u32x4 w = {r0[0], r1[0], r0[1], r1[1]}; OUT = *reinterpret_cast<bf16x8*>(&w); } while (0)
    PK4(p0, 0, pa0); PK4(p0, 8, pa1); PK4(p1, 0, pa2); PK4(p1, 8, pa3);
#undef PK4
}
__device__ __forceinline__ int v_st(int k, int c) { const int kk = (k & ~0xC) | ((k & 4) << 1) | ((k & 8) >> 1); return ((kk >> 3) * 4 + (c >> 5)) * 512 + ((kk & 7) * 32 + (c & 31)) * 2; }
__device__ __forceinline__ int v_rd_base(int lane) { return ((lane & 3) << 3) | (((lane >> 2) & 3) << 6) | (((lane >> 4) & 1) << 5) | (((lane >> 5) & 1) << 8); }
constexpr int v_rd_off(int d0, int ks, int half) { return d0 * 512 + ks * 4096 + half * 2048; }
template <int OFF> __device__ __forceinline__ s16x4 tr_read(int vb) {
    s16x4 r; asm volatile("ds_read_b64_tr_b16 %0, %1 offset:%2" : "=&v"(r) : "v"(vb), "i"(OFF) : "memory"); return r;
}
template <int D0> __device__ __forceinline__ void pv_one(f32x16& od, int vb, bf16x8 pa0, bf16x8 pa1, bf16x8 pa2, bf16x8 pa3) {
    const s16x4 l0 = tr_read<v_rd_off(D0, 0, 0)>(vb), h0 = tr_read<v_rd_off(D0, 0, 1)>(vb), l1 = tr_read<v_rd_off(D0, 1, 0)>(vb), h1 = tr_read<v_rd_off(D0, 1, 1)>(vb);
    const s16x4 l2 = tr_read<v_rd_off(D0, 2, 0)>(vb), h2 = tr_read<v_rd_off(D0, 2, 1)>(vb), l3 = tr_read<v_rd_off(D0, 3, 0)>(vb), h3 = tr_read<v_rd_off(D0, 3, 1)>(vb);
    asm volatile("s_waitcnt lgkmcnt(0)" ::: "memory"); SBAR();
#define PK(L, H) (bf16x8){L[0], L[1], L[2], L[3], H[0], H[1], H[2], H[3]}
    od = __builtin_amdgcn_mfma_f32_32x32x16_bf16(pa0, PK(l0, h0), od, 0, 0, 0);
    od = __builtin_amdgcn_mfma_f32_32x32x16_bf16(pa1, PK(l1, h1), od, 0, 0, 0);
    od = __builtin_amdgcn_mfma_f32_32x32x16_bf16(pa2, PK(l2, h2), od, 0, 0, 0);
    od = __builtin_amdgcn_mfma_f32_32x32x16_bf16(pa3, PK(l3, h3), od, 0, 0, 0);
#undef PK
}
__device__ __forceinline__ void attn_unit(const bf16_t* __restrict__ Qb, const bf16_t* __restrict__ Kh, const bf16_t* __restrict__ Vh, bf16_t* __restrict__ Ob, char* lds, const int tid_in) {
    int tid = threadIdx.x; asm volatile("" : "+v"(tid)); (void)tid_in;
    const int wid = tid >> 6, lane = tid & 63, r32 = lane & 31, hi = lane >> 5;
    char* V_lds = lds + V_OFF; char* K_lds = lds + K_OFF;
    float* ws = (float*)(lds + WS_OFF) + wid * 64; float* li_l = ws; float* al_l = ws + 32;
    float m_reg = -1e30f, l_reg = 0; f32x16 o0 = {}, o1 = {}, o2 = {}, o3 = {}; bf16x8 qr[12];
    const bf16_t* Qw = Qb + (size_t)(wid * 32 + r32) * LDQ + hi * 8;
#pragma unroll
    for (int d0 = 0; d0 < 12; ++d0) qr[d0] = *(const bf16x8*)(Qw + d0 * 16);
    LAS unsigned char* ldsl = (LAS unsigned char*)lds;
    unsigned kof[3], vof[2];
#pragma unroll
    for (int i = 0; i < 3; ++i) { const int p = (i * 8 + wid) * 64 + lane, row = p / 24, chs = p % 24, ch = (chs & ~7) | ((chs ^ row) & 7); kof[i] = (unsigned)(row * LDK + ch * 8) * 2u; }
#pragma unroll
    for (int i = 0; i < 2; ++i) { const int p = (i * 8 + wid) * 64 + lane, sub = p >> 5, kkh = sub >> 2, chh = sub & 3, kkl = (p & 31) >> 2, cl = (p & 3) * 8;
        const int kk = kkh * 8 + kkl, k = (kk & ~0xC) | ((kk & 4) << 1) | ((kk & 8) >> 1), c = chh * 32 + cl; vof[i] = (unsigned)(k * LDV + c) * 2u; }
    const int vb0 = (int)(uintptr_t)V_lds + v_rd_base(lane);
    const int wofs = __builtin_amdgcn_readfirstlane(wid) * 1024;
#define SDMA(k0, b) do { \
    _Pragma("unroll") for (int _i = 0; _i < 3; ++_i) __builtin_amdgcn_global_load_lds((const unsigned*)((const char*)Kh + (size_t)(k0) * LDK * 2 + kof[_i]), (LAS unsigned*)(ldsl + K_OFF + (b) * KT_BYTES + _i * 8192 + wofs), 16, 0, 0); \
    _Pragma("unroll") for (int _i = 0; _i < 2; ++_i) __builtin_amdgcn_global_load_lds((const unsigned*)((const char*)Vh + (size_t)(k0) * LDV * 2 + vof[_i]), (LAS unsigned*)(ldsl + V_OFF + (b) * VT_BYTES + _i * 8192 + wofs), 16, 0, 0); } while (0)
    constexpr int NT = SEQ / 64;
    SDMA(0, 0); asm volatile("s_waitcnt vmcnt(0)" ::: "memory"); __syncthreads();
    for (int j = 0; j < NT; ++j) {
        const int cur = j & 1;
        if (j + 1 < NT) SDMA((j + 1) * 64, cur ^ 1);
        f32x16 p0 = {}, p1 = {};
        const char* Ks = K_lds + cur * KT_BYTES;
#pragma unroll
        for (int d0 = 0; d0 < 12; ++d0) { const int cb = (d0 * 16 + hi * 8) * 2;
            const bf16x8 b0 = *(const bf16x8*)(Ks + KSWZ(r32, cb));
            const bf16x8 b1 = *(const bf16x8*)(Ks + KSWZ(32 + r32, cb));
            p0 = __builtin_amdgcn_mfma_f32_32x32x16_bf16(b0, qr[d0], p0, 0, 0, 0);
            p1 = __builtin_amdgcn_mfma_f32_32x32x16_bf16(b1, qr[d0], p1, 0, 0, 0); }
        float mn, alpha; bf16x8 pa0, pa1, pa2, pa3;
        partialSM(p0, p1, m_reg, mn, alpha);
        if (__any(alpha < 1.f)) { if (hi == 0) al_l[r32] = alpha; asm volatile("s_waitcnt lgkmcnt(0)" ::: "memory");
#pragma unroll
            for (int r = 0; r < 16; ++r) { const float a = al_l[crow(r, hi)]; o0[r] *= a; o1[r] *= a; o2[r] *= a; o3[r] *= a; } }
        finishSM(p0, p1, alpha, l_reg, pa0, pa1, pa2, pa3);
        const int vb = vb0 + cur * VT_BYTES;
        pv_one<0>(o0, vb, pa0, pa1, pa2, pa3); pv_one<1>(o1, vb, pa0, pa1, pa2, pa3); pv_one<2>(o2, vb, pa0, pa1, pa2, pa3); pv_one<3>(o3, vb, pa0, pa1, pa2, pa3);
        asm volatile("s_waitcnt vmcnt(0)" ::: "memory");
        __syncthreads();
    }
    if (hi == 0) li_l[r32] = l_reg; asm volatile("s_waitcnt lgkmcnt(0)" ::: "memory");
    bf16_t* Ow = Ob + (size_t)(wid * 32) * LDO;
#pragma unroll
    for (int r = 0; r < 16; ++r) { const int orow = crow(r, hi); const float rl = __builtin_amdgcn_rcpf(li_l[orow]);
        bf16_t* op = Ow + (size_t)orow * LDO + r32;
        op[0] = (bf16_t)(cvt_pk_bf16(o0[r] * rl, 0.f) & 0xffffu); op[32] = (bf16_t)(cvt_pk_bf16(o1[r] * rl, 0.f) & 0xffffu);
        op[64] = (bf16_t)(cvt_pk_bf16(o2[r] * rl, 0.f) & 0xffffu); op[96] = (bf16_t)(cvt_pk_bf16(o3[r] * rl, 0.f) & 0xffffu); }
    __syncthreads();
#undef SDMA
}
}


template <int MODE>
__device__ __forceinline__ void tr_item(const float* W, int K, int Nsrc, bf16_t* WT, int nrow0, int srccol0, bool zero, const float* kscale, int k0, LAS float* scr, int lane, float (&v)[32]) {
    if (MODE == 0) {
#pragma unroll
        for (int i = 0; i < 32; ++i) { const int kk = 2 * i + (lane >> 5);
            float x = 0.f; if (!zero) { x = __builtin_nontemporal_load(W + (size_t)(k0 + kk) * Nsrc + srccol0 + (lane & 31)); if (kscale) x *= kscale[k0 + kk]; }
            v[i] = x; }
    } else {
        const int c = lane & 7;
#pragma unroll
        for (int j = 0; j < 4; ++j) { const int n = (lane >> 3) + 8 * j; const LAS float* s = scr + (8 * c) * 33 + n;
            u32x4 o; o.x = cvt_pk_bf16(s[0 * 33], s[1 * 33]); o.y = cvt_pk_bf16(s[2 * 33], s[3 * 33]); o.z = cvt_pk_bf16(s[4 * 33], s[5 * 33]); o.w = cvt_pk_bf16(s[6 * 33], s[7 * 33]);
            *(u32x4*)(WT + (size_t)(nrow0 + n) * K + k0 + 8 * c) = o; }
        asm volatile("s_waitcnt lgkmcnt(0)" ::: "memory");
    }
}
template <int MODE>
__device__ __forceinline__ void tr_matrix_item(int it, ArgsP a, LAS float* scr, int lane, float (&v)[32]) {
    constexpr int C0 = 16 * 192, C1 = C0 + 32 * 32, C2 = C1 + 16 * 24, C3 = C2 + 6 * 48, C4 = C3 + 4 * 64, C5 = C4 + 16 * 32, C6 = C5 + 16 * 128, C7 = C6 + 16 * 128, C8 = C7 + 64 * 32;
    int item, id;
    if (it < C0) { id = 0; item = it; } else if (it < C1) { id = 1; item = it - C0; } else if (it < C2) { id = 2; item = it - C1; } else if (it < C3) { id = 3; item = it - C2; }
    else if (it < C4) { id = 4; item = it - C3; } else if (it < C5) { id = 5; item = it - C4; } else if (it < C6) { id = 6; item = it - C5; } else if (it < C7) { id = 7; item = it - C6; }
    else if (it < C8) { id = 8; item = it - C7; } else { id = 9; item = it - C8; }
    const float* W; int K, Nsrc, Ndst; bf16_t* WT; const float* ksc = nullptr;
    unsigned char* ws = a->ws;
    switch (id) {
    case 0: W = a->in[6]; K = 1024; Nsrc = 6144; Ndst = 6144; WT = (bf16_t*)(ws + WS_RWIN); break;
    case 1: W = a->in[10]; K = 2048; Nsrc = 1024; Ndst = 1024; WT = (bf16_t*)(ws + WS_RWOUT); break;
    case 2: W = a->in[11]; K = 1024; Nsrc = 704; Ndst = 768; WT = (bf16_t*)(ws + WS_MWIN); break;
    case 3: W = a->in[13]; K = 384; Nsrc = 1536; Ndst = 1536; WT = (bf16_t*)(ws + WS_MWUQ); ksc = a->in[12]; break;
    case 4: W = a->in[15]; K = 256; Nsrc = 2048; Ndst = 2048; WT = (bf16_t*)(ws + WS_MWUKV); ksc = a->in[14]; break;
    case 5: W = a->in[16]; K = 1024; Nsrc = 1024; Ndst = 1024; WT = (bf16_t*)(ws + WS_MWOUT); break;
    case 6: W = a->in[17]; K = 1024; Nsrc = 4096; Ndst = 4096; WT = (bf16_t*)(ws + WS_W1); break;
    case 7: W = a->in[17] + (size_t)1024 * 4096; K = 1024; Nsrc = 4096; Ndst = 4096; WT = (bf16_t*)(ws + WS_W1) + (size_t)4096 * 1024; break;
    case 8: W = a->in[18]; K = 4096; Nsrc = 1024; Ndst = 1024; WT = (bf16_t*)(ws + WS_W2); break;
    default: W = a->in[18] + (size_t)4096 * 1024; K = 4096; Nsrc = 1024; Ndst = 1024; WT = (bf16_t*)(ws + WS_W2) + (size_t)1024 * 4096; break;
    }
    const int nblk = Ndst / 32, kb = item / nblk, nb = item % nblk, n0 = nb * 32;
    int src0 = n0; bool zero = false;
    if (id == 2) zero = (n0 >= 704);
    if (id == 3) {
        if (n0 < 1024) { src0 = (n0 >> 7) * 192 + (n0 & 127); }
        else { const int r = n0 - 1024, t = r >> 8, cc = r & 255, half = cc >> 7, hh = (cc & 127) >> 5; src0 = (4 * t + hh) * 192 + 128 + half * 32; }
    }
    tr_item<MODE>(W, K, Nsrc, WT, n0, src0, zero, ksc, kb * 64, scr, lane, v);
}
__device__ __forceinline__ void prep_phase(ArgsP a, char* lds_g, int G, const int tid_in) {
    LAS unsigned char* lds = (LAS unsigned char*)lds_g;
    int tid = threadIdx.x; asm volatile("" : "+v"(tid)); (void)tid_in;
    const int lane = tid & 63, wave = tid >> 6;
    unsigned char* ws = a->ws;
    {
        LAS float* scr = (LAS float*)(lds + wave * 16384);
        const int gw = blockIdx.x * 8 + wave, NGW = G * 8;
        constexpr int C9 = 16 * 192 + 32 * 32 + 16 * 24 + 6 * 48 + 4 * 64 + 16 * 32 + 16 * 128 + 16 * 128 + 64 * 32 + 64 * 32;
        float v[32];
        int it = gw;
        if (it < C9) tr_matrix_item<0>(it, a, scr, lane, v);
        while (it < C9) {
#pragma unroll
            for (int i = 0; i < 32; ++i) scr[(2 * i + (lane >> 5)) * 33 + (lane & 31)] = v[i];
            asm volatile("s_waitcnt lgkmcnt(0)" ::: "memory");
            const int nxt = it + NGW;
            if (nxt < C9) tr_matrix_item<0>(nxt, a, scr, lane, v);
            tr_matrix_item<1>(it, a, scr, lane, v);
            it = nxt;
        }
    }
    __syncthreads();
    {
        LAS float* cact = (LAS float*)lds; LAS float* red = (LAS float*)(lds + 65536);
        const float* c = a->in[1];
        for (int i = tid; i < 16384; i += 512) { const float v = c[i]; cact[i] = v / (1.0f + __expf(-v)); }
        __syncthreads();
        float* mod = (float*)(ws + WS_MOD);
        for (int u = blockIdx.x; u < 768; u += G) {
            const int l = u / 384, r_ = u % 384, cgp = r_ >> 2, kq = r_ & 3, col = cgp * 64 + lane;
            float accv[16];
#pragma unroll
            for (int b = 0; b < 16; ++b) accv[b] = 0.f;
            const int kb0 = kq * 256 + wave * 32;
            const float* w = a->in[4] + (size_t)l * 1024 * 6144 + (size_t)kb0 * 6144 + col;
            float wv[32];
#pragma unroll
            for (int k = 0; k < 32; ++k) wv[k] = __builtin_nontemporal_load(w + (size_t)k * 6144);
#pragma unroll
            for (int k = 0; k < 32; ++k) {
#pragma unroll
                for (int b = 0; b < 16; ++b) accv[b] = fmaf(cact[b * 1024 + kb0 + k], wv[k], accv[b]); }
#pragma unroll
            for (int b = 0; b < 16; ++b) red[(wave * 16 + b) * 64 + lane] = accv[b];
            __syncthreads();
            for (int o = tid; o < 1024; o += 512) { const int b = o >> 6, cc = o & 63; float s = 0.f;
#pragma unroll
                for (int kg = 0; kg < 8; ++kg) s += red[(kg * 16 + b) * 64 + cc];
                if (kq == 0) s += a->in[5][l * 6144 + cgp * 64 + cc];
                atomicAdd(&mod[(size_t)(l * 16 + b) * 6144 + cgp * 64 + cc], s); }
            __syncthreads();
        }
    }
    {
        const size_t gt = (size_t)blockIdx.x * 512 + tid, NT_ = (size_t)G * 512;
        const int* pos = (const int*)a->in[2];
        f32x2* tab = (f32x2*)(ws + WS_R3);
        for (size_t idx = gt; idx < (size_t)T_TOK * 128; idx += NT_) { const int t = (int)(idx >> 7), j = (int)(idx & 127);
            const float ang = (float)pos[t] * INVF_RET[j]; float s, c; sincos_f(ang, s, c);
            tab[idx] = (f32x2){c, s}; }
        float* z1 = (float*)(ws + WS_SSQQ); float* z2 = (float*)(ws + WS_SSQKV); float* z3 = (float*)(ws + WS_GN);
        for (size_t idx = gt; idx < (size_t)T_TOK; idx += NT_) { z1[idx] = 0.f; z2[idx] = 0.f; }
        for (size_t idx = gt; idx < (size_t)T_TOK * 8; idx += NT_) z3[idx] = 0.f;
        if (gt < 8) { const float x = (gt < 4) ? a->in[7][gt] : a->in[8][gt - 4]; ((float*)(ws + WS_DEC))[gt] = -log1pf(expf(-x)) * 1.4426950408889634f; }
    }
}

struct RowJob { const float* xin; const bf16_t* y; const float* wpost; const float* gate; float* xout; const float* wpre; const float* sc; const float* sh; bf16_t* hdn; int mla_tab; };
__device__ __forceinline__ void row_phase(const RowJob& R, ArgsP a, int G, const int tid_in) {
    int tid = threadIdx.x; asm volatile("" : "+v"(tid)); (void)tid_in;
    const int lane = tid & 63, wave = tid >> 6;
    const int gw = blockIdx.x * 8 + wave, NGW = G * 8;
    constexpr int RPW = 16;
    for (int chunk = gw; chunk < T_TOK / RPW; chunk += NGW) {
        const int row0 = chunk * RPW, b = row0 >> 11;
        f32x4 A1[4], B1[4], SH[4];
#pragma unroll
        for (int j = 0; j < 4; ++j) {
            if (R.y) { const f32x4 w = ((const f32x4*)R.wpost)[lane + 64 * j], g = ((const f32x4*)(R.gate + (size_t)b * 6144))[lane + 64 * j]; A1[j] = w * g; }
            else A1[j] = (f32x4){0.f, 0.f, 0.f, 0.f};
            if (R.hdn) { const f32x4 w = ((const f32x4*)R.wpre)[lane + 64 * j], sc = ((const f32x4*)(R.sc + (size_t)b * 6144))[lane + 64 * j]; B1[j] = w * (1.0f + sc); SH[j] = ((const f32x4*)(R.sh + (size_t)b * 6144))[lane + 64 * j]; }
            else { B1[j] = (f32x4){0.f, 0.f, 0.f, 0.f}; SH[j] = B1[j]; }
        }
        f32x4 v[4], vn[4]; u32x2 yw[4], ywn[4];
        {
            const f32x4* xr = (const f32x4*)(R.xin + (size_t)row0 * DM) + lane;
#pragma unroll
            for (int j = 0; j < 4; ++j) v[j] = __builtin_nontemporal_load(xr + 64 * j);
            if (R.y) { const u32x2* yr = (const u32x2*)(R.y + (size_t)row0 * DM) + lane;
#pragma unroll
                for (int j = 0; j < 4; ++j) yw[j] = __builtin_nontemporal_load(yr + 64 * j); }
        }
        for (int rr = 0; rr < RPW; ++rr) {
            const int row = row0 + rr;
            if (rr + 1 < RPW) {
                const f32x4* xr = (const f32x4*)(R.xin + (size_t)(row + 1) * DM) + lane;
#pragma unroll
                for (int j = 0; j < 4; ++j) vn[j] = __builtin_nontemporal_load(xr + 64 * j);
                if (R.y) { const u32x2* yr = (const u32x2*)(R.y + (size_t)(row + 1) * DM) + lane;
#pragma unroll
                    for (int j = 0; j < 4; ++j) ywn[j] = __builtin_nontemporal_load(yr + 64 * j); }
            }
            if (R.y) {
                f32x4 y[4]; float s = 0.f;
#pragma unroll
                for (int j = 0; j < 4; ++j) { const u32x2 w = yw[j]; y[j][0] = bf2f(w.x & 0xffffu); y[j][1] = bf2f(w.x >> 16); y[j][2] = bf2f(w.y & 0xffffu); y[j][3] = bf2f(w.y >> 16);
                    s += (y[j][0] * y[j][0] + y[j][1] * y[j][1]) + (y[j][2] * y[j][2] + y[j][3] * y[j][3]); }
                const float rstd = 1.0f / sqrtf(wave_sum(s) * (1.0f / DM) + 1e-6f);
                f32x4* xo = (f32x4*)(R.xout + (size_t)row * DM) + lane;
#pragma unroll
                for (int j = 0; j < 4; ++j) { v[j] = v[j] + (y[j] * rstd) * A1[j]; __builtin_nontemporal_store(v[j], xo + 64 * j); }
            }
            if (R.hdn) {
                float s = 0.f;
#pragma unroll
                for (int j = 0; j < 4; ++j) s += (v[j][0] * v[j][0] + v[j][1] * v[j][1]) + (v[j][2] * v[j][2] + v[j][3] * v[j][3]);
                const float rstd = 1.0f / sqrtf(wave_sum(s) * (1.0f / DM) + 1e-6f);
                u32x2* ho = (u32x2*)(R.hdn + (size_t)row * DM) + lane;
#pragma unroll
                for (int j = 0; j < 4; ++j) { const f32x4 h = (v[j] * rstd) * B1[j] + SH[j]; u32x2 o; o.x = cvt_pk_bf16(h[0], h[1]); o.y = cvt_pk_bf16(h[2], h[3]); ho[64 * j] = o; }
            }
#pragma unroll
            for (int j = 0; j < 4; ++j) { v[j] = vn[j]; yw[j] = ywn[j]; }
        }
    }
    if (R.mla_tab) {
        const size_t gt = (size_t)blockIdx.x * 512 + tid, NT_ = (size_t)G * 512;
        const int* pos = (const int*)a->in[2];
        f32x2* tab = (f32x2*)(a->ws + WS_R3 + 64 * MiB);
        for (size_t idx = gt; idx < (size_t)T_TOK * 32; idx += NT_) { const int t = (int)(idx >> 5), j = (int)(idx & 31);
            const float ang = (float)pos[t] * INVF_MLA[j]; float s, c; sincos_f(ang, s, c);
            tab[idx] = (f32x2){c, s}; }
    }
}


__device__ __forceinline__ void mla_table_half(ArgsP a, int G) {
    int tid = threadIdx.x; asm volatile("" : "+v"(tid));
    const int half = (G % 2 == 0) ? G / 2 : 0;
    if ((int)blockIdx.x < half) return;
    const size_t gt = (size_t)((int)blockIdx.x - half) * 512 + tid, NT_ = (size_t)(G - half) * 512;
    const int* pos = (const int*)a->in[2];
    f32x2* tab = (f32x2*)(a->ws + WS_R3 + 64 * MiB);
    for (size_t idx = gt; idx < (size_t)T_TOK * 32; idx += NT_) { const int t = (int)(idx >> 5), j = (int)(idx & 31);
        const float ang = (float)pos[t] * INVF_MLA[j]; float s, c; sincos_f(ang, s, c);
        tab[idx] = (f32x2){c, s}; }
}

#define XB_TMO      128
#define XB_XCNT(j)  (256  + 64 * (j))
#define XB_XSUB(j)  (1280 + 64 * (j))
#define XB_XGEN(j)  (2304 + 64 * (j))
#define XB_TOP      3328
#define XB_TOPGEN   3392
#define XCD_BAR_WORDS 3456
#define XB_SPIN_CAP (1u << 21)
__device__ __forceinline__ unsigned xb_ld(unsigned* p)              { return __hip_atomic_load(p, __ATOMIC_RELAXED, __HIP_MEMORY_SCOPE_AGENT); }
__device__ __forceinline__ unsigned xb_add(unsigned* p, unsigned v) { return __hip_atomic_fetch_add(p, v, __ATOMIC_RELAXED, __HIP_MEMORY_SCOPE_AGENT); }
__device__ __forceinline__ unsigned xb_xcc_id() { return (unsigned)__builtin_amdgcn_s_getreg((3 << 11) | 20) & 0xFu; }
#define XB_SPIN(cond, bar) do { unsigned _sp = 0; while (cond) { __builtin_amdgcn_s_sleep(1); \
    if ((++_sp & 255u) == 0u) { if (xb_ld(&(bar)[XB_TMO])) break; if (_sp > XB_SPIN_CAP) { atomicAdd(&(bar)[XB_TMO], 1u); break; } } } } while (0)
struct XcdBarrier { unsigned* bar; unsigned x; volatile LAS unsigned* st; };
__device__ __forceinline__ void xcd_barrier_complete(unsigned* bar, unsigned x, unsigned& nloc, unsigned& nx) {
    const unsigned G = gridDim.x * gridDim.y * gridDim.z;
    unsigned sum, cnt, mine, sp = 0u;
    for (;;) {
        sum = 0u; cnt = 0u; mine = 0u;
#pragma unroll
        for (unsigned j = 0; j < 16; ++j) { const unsigned c = xb_ld(&bar[XB_XCNT(j)]); sum += c; cnt += (c > 0u) ? 1u : 0u; mine = (j == x) ? c : mine; }
        if (sum == G) break;
        __builtin_amdgcn_s_sleep(1);
        if ((++sp & 255u) == 0u) { if (xb_ld(&bar[XB_TMO])) break; if (sp > XB_SPIN_CAP) { atomicAdd(&bar[XB_TMO], 1u); break; } }
    }
    nloc = mine > 0u ? mine : 1u; nx = cnt > 0u ? cnt : 1u;
}
__device__ __forceinline__ void xcd_barrier(const XcdBarrier& b) {
    asm volatile("s_waitcnt vmcnt(0)" ::: "memory");
    __syncthreads();
    if (threadIdx.x == 0) {
        unsigned* bar = b.bar;
        __builtin_amdgcn_s_waitcnt(0);
        unsigned nloc = b.st[0], nx = b.st[1];
        if (nloc == 0u) { xcd_barrier_complete(bar, b.x, nloc, nx); b.st[0] = nloc; b.st[1] = nx; }
        const unsigned old = xb_add(&bar[XB_XSUB(b.x)], 1u);
        const unsigned gen = old / nloc;
        if (old + 1u == (gen + 1u) * nloc) {
            __builtin_amdgcn_fence(__ATOMIC_RELEASE, "agent");
            asm volatile("s_waitcnt vmcnt(0)" ::: "memory");
            const unsigned og = xb_add(&bar[XB_TOP], 1u);
            const unsigned tg = og / nx;
            if (og + 1u == (tg + 1u) * nx) xb_add(&bar[XB_TOPGEN], 1u);
            else XB_SPIN(xb_ld(&bar[XB_TOPGEN]) == tg, bar);
            __builtin_amdgcn_fence(__ATOMIC_ACQUIRE, "agent");
            xb_add(&bar[XB_XGEN(b.x)], 1u);
            asm volatile("s_waitcnt vmcnt(0)" ::: "memory");
        } else {
            XB_SPIN(xb_ld(&bar[XB_XGEN(b.x)]) == gen, bar);
            __builtin_amdgcn_fence(__ATOMIC_ACQUIRE, "agent");
            asm volatile("s_waitcnt vmcnt(0)" ::: "memory");
        }
    }
    __syncthreads();
}

constexpr int NJOBS = 27;
enum { K_PREP = 0, K_ROW = 1, K_GEMM = 2, K_ATTN = 3, K_NONE = 5 };
__host__ __device__ __forceinline__ int job_sync_after(int j) { return !(j == 2 || (j >= 8 && j <= 11) || j == 19 || j == 26); }

__device__ __forceinline__ RowJob make_row(int j, ArgsP ap) {
    unsigned char* ws = ap->ws; const float* mod = (const float*)(ws + WS_MOD); const float* normw = ap->in[3]; float* out = ap->out;
    const int k = (j == 1) ? 0 : (j == 14) ? 1 : (j == 17) ? 2 : (j == 23) ? 3 : 4;
    RowJob r;
    r.xin = (k <= 1) ? ap->in[0] : (const float*)out;
    r.y = (k == 0) ? (const bf16_t*)nullptr : (const bf16_t*)(ws + ((k == 3) ? WS_R1 : WS_R3));
    r.wpost = normw + (2 * k - 1) * 1024;
    r.gate = mod + ((k >= 3) ? 16 * 6144 : 0) + ((k & 1) ? 2 : 5) * 1024;
    r.xout = out;
    r.wpre = normw + (2 * k) * 1024;
    r.sc = mod + ((k >= 2) ? 16 * 6144 : 0) + ((k & 1) ? 4 : 1) * 1024;
    r.sh = mod + ((k >= 2) ? 16 * 6144 : 0) + ((k & 1) ? 3 : 0) * 1024;
    r.hdn = (k == 4) ? (bf16_t*)nullptr : (bf16_t*)(ws + WS_HDN);
    r.mla_tab = 0;
    return r;
}
__device__ __forceinline__ GemmJob make_gemm(int j, unsigned char* ws, bf16_t* outb) {
    GemmJob g{}; g.zdiv = 1; g.nZ = 1;
    bf16_t* HDN = (bf16_t*)(ws + WS_HDN);
    bf16_t* R1 = (bf16_t*)(ws + WS_R1); bf16_t* R2 = (bf16_t*)(ws + WS_R2); bf16_t* R3 = (bf16_t*)(ws + WS_R3);
    if (j == 2) {
        g.A = HDN; g.lda = 1024; g.Bt = (const bf16_t*)(ws + WS_RWIN); g.ldb = 1024; g.K = 1024; g.nM = 128; g.nN = 8; g.epi = EPI_RETQK;
    } else if (j == 3) {
        g.A = (const bf16_t*)(ws + WS_RWIN) + (size_t)2048 * 1024; g.lda = 1024; g.Bt = HDN; g.ldb = 1024; g.K = 1024; g.nM = 8; g.nN = 8; g.nZ = 16; g.zBh = (long)2048 * 1024; g.epi = EPI_STORE; g.var = 0;
    } else if (j >= 4 && j <= 7) {
        const int grp = (j - 4) >> 1;
        if (((j - 4) & 1) == 0) {
            g.A = R1 + (size_t)grp * 8 * 2 * 2048 * 1024; g.lda = 1024; g.zdiv = 4; g.zAh = (long)2 * 2048 * 1024; g.zAl = 256;
            g.Bt = g.A + (size_t)2048 * 1024; g.ldb = 1024; g.zBh = g.zAh; g.zBl = 256;
            g.K = 256; g.nM = 8; g.nN = 8; g.nZ = 32; g.epi = EPI_SDECAY; g.var = grp;
        } else {
            g.A = R3; g.lda = 2048; g.zdiv = 16; g.zAh = (long)(outb - R3); g.zAl = (long)2048 * 2048;
            g.Bt = R2 + (size_t)grp * 8 * 2048 * 2048; g.ldb = 2048; g.zBh = (long)16 * 512 * 2048; g.zBl = (long)512 * 2048;
            g.K = 2048; g.nM = 8; g.nN = 2; g.nZ = 32; g.epi = EPI_OY; g.var = grp * 8; g.rev = 1;
        }
    } else if (j == 12) {
        g.A = HDN; g.lda = 1024; g.Bt = (const bf16_t*)(ws + WS_RWIN) + (size_t)4096 * 1024; g.ldb = 1024; g.K = 1024; g.nM = 128; g.nN = 8; g.epi = EPI_GATE;
    } else if (j == 13) {
        g.A = R1; g.lda = 2048; g.Bt = (const bf16_t*)(ws + WS_RWOUT); g.ldb = 2048; g.K = 2048; g.nM = 128; g.nN = 4; g.epi = EPI_STORE; g.var = 1;
    } else if (j == 15 || j == 24) {
        const int l = (j == 24);
        g.A = HDN; g.lda = 1024; g.Bt = (const bf16_t*)(ws + WS_W1) + (size_t)l * 4096 * 1024; g.ldb = 1024; g.K = 1024; g.nM = 128; g.nN = 16; g.epi = EPI_RELU2; g.var = 3;
    } else if (j == 16 || j == 25) {
        const int l = (j == 25);
        g.A = R1; g.lda = 4096; g.Bt = (const bf16_t*)(ws + WS_W2) + (size_t)l * 1024 * 4096; g.ldb = 4096; g.K = 4096; g.nM = 128; g.nN = 4; g.epi = EPI_STORE; g.var = 1;
    } else if (j == 18) {
        g.A = HDN; g.lda = 1024; g.Bt = (const bf16_t*)(ws + WS_MWIN); g.ldb = 1024; g.K = 1024; g.nM = 128; g.nN = 3; g.epi = EPI_WIN;
    } else if (j == 19) {
        g.A = R3; g.lda = 768; g.Bt = (const bf16_t*)(ws + WS_MWUQ); g.ldb = 384; g.K = 384; g.nM = 128; g.nN = 6; g.epi = EPI_UQ;
    } else if (j == 20) {
        g.A = R3 + 384; g.lda = 768; g.Bt = (const bf16_t*)(ws + WS_MWUKV); g.ldb = 256; g.K = 256; g.nM = 128; g.nN = 8; g.epi = EPI_UKV;
    } else {
        g.A = (const bf16_t*)(ws + WS_R3 + 64 * MiB); g.lda = 1024; g.Bt = (const bf16_t*)(ws + WS_MWOUT); g.ldb = 1024; g.K = 1024; g.nM = 128; g.nN = 4; g.epi = EPI_STORE; g.var = 2;
    }
    return g;
}

__global__ void __launch_bounds__(512, 2) fwd_megakernel(Args a) {
    extern __shared__ __attribute__((aligned(16))) unsigned char lds_raw[];
    const int G = gridDim.x;
    const int j_lo = a.j_lo, j_hi = a.j_hi;
    volatile LAS unsigned* xb_st = (volatile LAS unsigned*)((LAS unsigned char*)lds_raw + 131072 + 64);
    if (threadIdx.x < 2) xb_st[threadIdx.x] = 0u;
    __syncthreads();
    if (threadIdx.x == 0) (void)xb_add((unsigned*)(a.ws + WS_BAR) + XB_XCNT(xb_xcc_id()), 1u);
#if PROBE
    unsigned long long tprev = __builtin_amdgcn_s_memrealtime(); unsigned tc0 = 0, tc1 = 0, tc2 = 0, tc3 = 0, tc4 = 0, tc5 = 0, tc6 = 0;
#endif
    for (int j = j_lo; j < j_hi; ++j) {
        const int tidl = 0;
        ArgsP ap = (ArgsP)__builtin_amdgcn_kernarg_segment_ptr(); asm volatile("" : "+s"(ap));
        int kind;
        if (j == 0) kind = K_PREP;
        else if (j == 1 || j == 14 || j == 17 || j == 23 || j == 26) kind = K_ROW;
        else if (j == 21) kind = K_ATTN;
        else if (j >= 8 && j <= 11) kind = K_NONE;
        else kind = K_GEMM;
        switch (kind) {
#ifndef NO_PREP
        case K_PREP: prep_phase(ap, (char*)lds_raw, G, tidl); break;
#endif
#ifndef NO_ROW
        case K_ROW: { const RowJob r = make_row(j, ap); row_phase(r, ap, G, tidl); } break;
#endif
#ifndef NO_GEMM
        case K_GEMM: { const GemmJob g = make_gemm(j, ap->ws, (bf16_t*)ap->out); Sched S; S.init(g.nZ, g.nM, g.nN, G, (int)blockIdx.x, g.rev); gemm_phase((LAS unsigned char*)lds_raw, g, S, ap, tidl); } break;
#endif
#ifndef NO_ATTN
        case K_ATTN: {
            unsigned char* ws = ap->ws;
            const bf16_t* Q1 = (const bf16_t*)(ws + WS_R1); const bf16_t* K1 = Q1 + (size_t)T_TOK * 1536; const bf16_t* V1 = Q1 + (size_t)2 * T_TOK * 1536;
            bf16_t* O = (bf16_t*)(ws + WS_R3 + 64 * MiB);
            const int vcu = (G % 8 == 0) ? ((int)blockIdx.x % 8) * (G / 8) + (int)blockIdx.x / 8 : (int)blockIdx.x;
            for (int un = vcu; un < NB * 8 * 8; un += G) {
                const int bh = un >> 3, qb = un & 7, b = bh >> 3, h = bh & 7;
                mla::attn_unit(Q1 + ((size_t)(b * 2048 + qb * 256) * 1536 + h * 192), K1 + ((size_t)b * 2048 * 1536 + h * 192), V1 + ((size_t)b * 2048 * 1024 + h * 128),
                               O + ((size_t)(b * 2048 + qb * 256) * 1024 + h * 128), (char*)lds_raw, tidl);
            }
        } break;
#endif
        default: break;
        }
        if (j == 18) mla_table_half(ap, G);
#if PROBE
        __syncthreads(); cg::this_grid().sync();
        { const unsigned long long tn = __builtin_amdgcn_s_memrealtime(); const unsigned dt = (unsigned)(tn - tprev); tprev = tn;
          if (kind == K_PREP) tc0 += dt; else if (kind == K_ROW) tc1 += dt; else if (kind == K_ATTN) tc2 += dt;
          else if (j >= 4 && j <= 11) tc3 += dt; else if (j == 15 || j == 16 || j == 24 || j == 25) tc4 += dt; else tc5 += dt;
          if ((PROBE_MASK >> j) & 1u) tc6 += dt; }
#else
        if (job_sync_after(j) && j + 1 < j_hi) {
            if (j_hi < 0) { __syncthreads(); cg::this_grid().sync(); }
            { XcdBarrier xb; xb.bar = (unsigned*)(ap->ws + WS_BAR); xb.x = xb_xcc_id(); xb.st = xb_st; xcd_barrier(xb); }
        }
        else __syncthreads();
#endif
    }
#if PROBE
    if (blockIdx.x == 0) {
        const unsigned ta = (PROBE == 1) ? tc1 : (PROBE == 2) ? tc2 : (PROBE == 3) ? tc3 : (PROBE == 4) ? tc4 : (PROBE == 5) ? tc5 : (PROBE == 7) ? tc6 : tc0;
        float* out = a.out;
        for (int i = threadIdx.x; i < (1 << 16); i += 512) out[i] += (float)ta * 5.06e-7f;
    }
#endif
}

extern "C" void kernel_launch(void* const* d_in, const int* in_sizes, int n_in, void* d_out, int out_size, void* d_ws, size_t ws_size, hipStream_t stream) {
    static int grid = 0;
    if (grid == 0) {
        if (n_in != 19 || out_size != T_TOK * DM || ws_size < WS_END) { fprintf(stderr, "kernel_launch: unexpected shapes n_in %d out %d ws %zu (need %zu)\n", n_in, out_size, ws_size, (size_t)WS_END); grid = -1; return; }
        int dev = 0, cus = 0, per_cu = 0;
        hipGetDevice(&dev); hipDeviceGetAttribute(&cus, hipDeviceAttributeMultiprocessorCount, dev);
        if (hipFuncSetAttribute((const void*)fwd_megakernel, hipFuncAttributeMaxDynamicSharedMemorySize, LDS_BYTES) != hipSuccess) { fprintf(stderr, "kernel_launch: hipFuncSetAttribute failed\n"); grid = -1; return; }
        if (hipOccupancyMaxActiveBlocksPerMultiprocessor(&per_cu, (const void*)fwd_megakernel, 512, LDS_BYTES) != hipSuccess || per_cu < 1) { fprintf(stderr, "kernel_launch: occupancy query says %d\n", per_cu); per_cu = 1; }
        (void)hipGetLastError();
        grid = cus * 1;
        fprintf(stderr, "kernel_launch: grid %d (cus %d, per_cu %d)\n", grid, cus, per_cu);
    }
    if (grid < 0) return;
    if (hipMemsetAsync((char*)d_ws + WS_MOD, 0, WS_BAR + (size_t)XCD_BAR_WORDS * 4, stream) != hipSuccess) { fprintf(stderr, "kernel_launch: hipMemsetAsync failed\n"); return; }
    Args a{};
    for (int i = 0; i < 19; ++i) a.in[i] = (const float*)d_in[i];
    a.out = (float*)d_out; a.ws = (unsigned char*)d_ws;
#if MULTI_LAUNCH
    int lo = 0;
    for (int j = 0; j < NJOBS; ++j) {
        if (job_sync_after(j) || j == NJOBS - 1) {
            a.j_lo = lo; a.j_hi = j + 1; lo = j + 1;
            hipLaunchKernelGGL(fwd_megakernel, dim3(grid), dim3(512), LDS_BYTES, stream, a);
        }
    }
#else
    a.j_lo = 0; a.j_hi = NJOBS;
    void* args[] = {&a};
    hipError_t e = hipLaunchCooperativeKernel((const void*)fwd_megakernel, dim3(grid), dim3(512), args, LDS_BYTES, stream);
    if (e != hipSuccess) fprintf(stderr, "cooperative launch failed: %s (grid %d)\n", hipGetErrorString(e), grid);
#endif
}
```

```cpp
#include <hip/hip_runtime.h>
#include <hip/hip_cooperative_groups.h>
#include <cstdio>
#include <cstdint>
namespace cg = cooperative_groups;

#ifndef PROBE
#define PROBE 0
#endif
#ifndef PROBE_MASK
#define PROBE_MASK 0x5c0000u
#endif
#ifndef MULTI_LAUNCH
#define MULTI_LAUNCH 0
#endif

#define LAS __attribute__((address_space(3)))
typedef unsigned short bf16_t;
typedef short bf16x8 __attribute__((ext_vector_type(8)));
typedef short s16x4 __attribute__((ext_vector_type(4)));
typedef float f32x4 __attribute__((ext_vector_type(4)));
typedef float f32x2 __attribute__((ext_vector_type(2)));
typedef float f32x16 __attribute__((ext_vector_type(16)));
typedef unsigned u32x4 __attribute__((ext_vector_type(4)));
typedef unsigned u32x2 __attribute__((ext_vector_type(2)));

constexpr int T_TOK = 32768, DM = 1024, NB = 16, SEQ = 2048;
constexpr size_t MiB = 1u << 20;
constexpr size_t WS_MOD = 0;
constexpr size_t WS_BAR = 768 * 1024;
constexpr size_t WS_SSQQ = 1 * MiB;
constexpr size_t WS_SSQKV = 1 * MiB + 256 * 1024;
constexpr size_t WS_DEC = 1 * MiB + 512 * 1024;
constexpr size_t WS_GN = 2 * MiB;
constexpr size_t WS_RWIN = 4 * MiB;
constexpr size_t WS_RWOUT = 16 * MiB;
constexpr size_t WS_MWIN = 20 * MiB;
constexpr size_t WS_MWUQ = 22 * MiB;
constexpr size_t WS_MWUKV = 24 * MiB;
constexpr size_t WS_MWOUT = 25 * MiB;
constexpr size_t WS_W1 = 28 * MiB;
constexpr size_t WS_W2 = 44 * MiB;
constexpr size_t WS_HDN = 60 * MiB;
constexpr size_t WS_R1 = 124 * MiB;
constexpr size_t WS_R2 = 252 * MiB;
constexpr size_t WS_R3 = 380 * MiB;
constexpr size_t WS_END = 508 * MiB;

constexpr int LDS_BYTES = 132096;

struct Args { const float* in[19]; float* out; unsigned char* ws; int j_lo, j_hi; };
typedef const __attribute__((address_space(4))) Args* ArgsP;

__device__ __forceinline__ unsigned cvt_pk_bf16(float lo, float hi) { unsigned r; asm volatile("v_cvt_pk_bf16_f32 %0, %1, %2" : "=v"(r) : "v"(lo), "v"(hi)); return r; }
__device__ __forceinline__ float bf2f(unsigned h) { return __uint_as_float(h << 16); }
__device__ __forceinline__ u32x4 pack8(f32x4 a, f32x4 b) { u32x4 w; w.x = cvt_pk_bf16(a[0], a[1]); w.y = cvt_pk_bf16(a[2], a[3]); w.z = cvt_pk_bf16(b[0], b[1]); w.w = cvt_pk_bf16(b[2], b[3]); return w; }
__device__ __forceinline__ float wave_sum(float v) {
#pragma unroll
    for (int o = 1; o < 64; o <<= 1) v += __shfl_xor(v, o);
    return v;
}
__device__ const float INVF_RET[128] = {1.000000000e+00f, 9.305720329e-01f, 8.659643531e-01f, 8.058421612e-01f, 7.498942018e-01f, 6.978305578e-01f, 6.493816376e-01f, 6.042963862e-01f, 5.623413324e-01f, 5.232990980e-01f, 4.869675338e-01f, 4.531583786e-01f, 4.216965139e-01f, 3.924189806e-01f, 3.651741147e-01f, 3.398208320e-01f, 3.162277639e-01f, 2.942727208e-01f, 2.738419771e-01f, 2.548296750e-01f, 2.371373773e-01f, 2.206734121e-01f, 2.053525001e-01f, 1.910952926e-01f, 1.778279394e-01f, 1.654817164e-01f, 1.539926529e-01f, 1.433012635e-01f, 1.333521456e-01f, 1.240937784e-01f, 1.154781953e-01f, 1.074607819e-01f, 1.000000015e-01f, 9.305720776e-02f, 8.659642935e-02f, 8.058422059e-02f, 7.498942316e-02f, 6.978306174e-02f, 6.493816525e-02f, 6.042964011e-02f, 5.623413250e-02f, 5.232991278e-02f, 4.869675264e-02f, 4.531583562e-02f, 4.216964915e-02f, 3.924189880e-02f, 3.651741147e-02f, 3.398208320e-02f, 3.162277490e-02f, 2.942727134e-02f, 2.738419548e-02f, 2.548296750e-02f, 2.371373773e-02f, 2.206734009e-02f, 2.053525113e-02f, 1.910953037e-02f, 1.778279431e-02f, 1.654817164e-02f, 1.539926510e-02f, 1.433012541e-02f, 1.333521400e-02f, 1.240937784e-02f, 1.154781971e-02f, 1.074607857e-02f, 9.999999776e-03f, 9.305720218e-03f, 8.659643121e-03f, 8.058422245e-03f, 7.498942316e-03f, 6.978305988e-03f, 6.493816152e-03f, 6.042963825e-03f, 5.623413250e-03f, 5.232991185e-03f, 4.869675264e-03f, 4.531583749e-03f, 4.216964822e-03f, 3.924189601e-03f, 3.651741194e-03f, 3.398208413e-03f, 3.162277630e-03f, 2.942727180e-03f, 2.738419687e-03f, 2.548296703e-03f, 2.371373819e-03f, 2.206734149e-03f, 2.053525066e-03f, 1.910952968e-03f, 1.778279431e-03f, 1.654817141e-03f, 1.539926510e-03f, 1.433012541e-03f, 1.333521446e-03f, 1.240937738e-03f, 1.154782018e-03f, 1.074607833e-03f, 1.000000047e-03f, 9.305720450e-04f, 8.659643354e-04f, 8.058421663e-04f, 7.498941850e-04f, 6.978305755e-04f, 6.493816036e-04f, 6.042963942e-04f, 5.623413017e-04f, 5.232990952e-04f, 4.869675322e-04f, 4.531583691e-04f, 4.216965172e-04f, 3.924189659e-04f, 3.651741135e-04f, 3.398208355e-04f, 3.162277571e-04f, 2.942727297e-04f, 2.738419571e-04f, 2.548296761e-04f, 2.371373703e-04f, 2.206734061e-04f, 2.053525095e-04f, 1.910952997e-04f, 1.778279402e-04f, 1.654817170e-04f, 1.539926598e-04f, 1.433012512e-04f, 1.333521504e-04f, 1.240937709e-04f, 1.154782003e-04f, 1.074607862e-04f};
__device__ const float INVF_MLA[32] = {1.000000000e+00f, 7.498942018e-01f, 5.623413324e-01f, 4.216965139e-01f, 3.162277639e-01f, 2.371373773e-01f, 1.778279394e-01f, 1.333521456e-01f, 1.000000015e-01f, 7.498942316e-02f, 5.623413250e-02f, 4.216964915e-02f, 3.162277490e-02f, 2.371373773e-02f, 1.778279431e-02f, 1.333521400e-02f, 9.999999776e-03f, 7.498942316e-03f, 5.623413250e-03f, 4.216964822e-03f, 3.162277630e-03f, 2.371373819e-03f, 1.778279431e-03f, 1.333521446e-03f, 1.000000047e-03f, 7.498941850e-04f, 5.623413017e-04f, 4.216965172e-04f, 3.162277571e-04f, 2.371373703e-04f, 1.778279402e-04f, 1.333521504e-04f};
__device__ __forceinline__ void sincos_f(float x, float& s, float& c) {
    const float n = rintf(x * 0.636619772f);
    float r = fmaf(-n, 1.57079637050628662109375f, x); r = fmaf(-n, -4.37113900018624283e-8f, r); r = fmaf(-n, -1.7151245100059e-15f, r);
    const int q = ((int)n) & 3; const float r2 = r * r;
    const float sp = fmaf(fmaf(fmaf(-1.9515295891e-4f, r2, 8.3321608736e-3f), r2, -1.6666654611e-1f) * r2, r, r);
    const float cp = fmaf(fmaf(fmaf(2.443315711809948e-5f, r2, -1.388731625493765e-3f), r2, 4.166664568298827e-2f), r2 * r2, fmaf(-0.5f, r2, 1.0f));
    s = (q == 0) ? sp : (q == 1) ? cp : (q == 2) ? -sp : -cp;
    c = (q == 0) ? cp : (q == 1) ? -sp : (q == 2) ? -cp : sp;
}

constexpr int BM = 256, BK = 64, HALF = 128, HTB = HALF * BK * 2, NXCD = 8, WGM = 8;
__device__ __forceinline__ int lds_byte(int r, int c) { const int st = (r >> 4) * 2 + (c >> 5), rr = r & 15, cc = c & 31, ob = rr * 64 + cc * 2; return st * 1024 + (ob ^ (((ob >> 9) & 1) << 5)); }
__device__ __forceinline__ void stage_rc(int b, int& R, int& C) { const int st = b / 1024, sb = b % 1024, swz = sb ^ (((sb >> 9) & 1) << 5); R = (st >> 1) * 16 + swz / 64; C = (st & 1) * 32 + (swz % 64) / 2; }
__device__ __forceinline__ int perm32(int rho) { const int n = rho >> 4, i = rho & 15; return 8 * (i >> 2) + 4 * n + (i & 3); }

struct Unit { int z, pm, pn; };
enum { EPI_RETQK = 0, EPI_STORE = 1, EPI_RELU2 = 2, EPI_SDECAY = 3, EPI_OY = 4, EPI_GATE = 5, EPI_WIN = 6, EPI_UQ = 7, EPI_UKV = 8 };
struct GemmJob {
    const bf16_t* A; const bf16_t* Bt; int lda, ldb, K, nM, nN, nZ;
    long zAh, zAl, zBh, zBl; int zdiv;
    int epi; int var;
    int rev;
};
struct EpiPtr { bf16_t* out; bf16_t* out2; int ldc; long zC; const float* f0; const float* f1; float* s0; float* s1; const bf16_t* b0; };
struct Sched {
    int nM, nN, nwg, per, G, c, rev;
    __device__ __forceinline__ void init(int nZ, int nM_, int nN_, int G_, int c_, int rev_ = 0) { nM = nM_; nN = nN_; per = nM * nN; nwg = nZ * per; G = G_; c = c_; rev = rev_; }
    __device__ __forceinline__ bool next(int i, Unit& u) const {
        const long L = (long)i * G + c; if (L >= nwg) return false;
        int wgid = (int)L; { const int q = nwg / NXCD, r = nwg % NXCD, xcd = wgid % NXCD; int off = wgid / NXCD; if (rev && r == 0) off = q - 1 - off; wgid = (xcd < r ? xcd * (q + 1) : r * (q + 1) + (xcd - r) * q) + off; }
        u.z = wgid / per; const int w = wgid % per;
        const int nig = WGM * nN, gid = w / nig, fm = gid * WGM, gsz = (nM - fm) < WGM ? (nM - fm) : WGM;
        u.pm = fm + ((w % nig) % gsz); u.pn = (w % nig) / gsz; return true;
    }
};

typedef f32x4 Acc[2][2][4][2];

#ifndef EPI_MASK
#define EPI_MASK 0x1ff
#endif
#define EPI_FENCE() asm volatile("" ::: "memory")
__device__ __forceinline__ void epilogue(const Acc& acc, const Unit& u, int wr, int wc, int fr_in, int fq_in, const int epi, const int var, ArgsP ap) {
    unsigned char* ws = ap->ws;
    int fr = fr_in, fq = fq_in; asm volatile("" : "+v"(fr), "+v"(fq));
    const int rowb = u.pm * BM + wr * 64 + fr;
    const int colb = wc * 32 + 8 * fq;
    EpiPtr J{};
    switch (epi) {
    case EPI_RETQK: { if (!((EPI_MASK >> EPI_RETQK) & 1)) break;
        J.out = (bf16_t*)(ws + WS_R1); J.f0 = (const float*)(ws + WS_R3);
        const int kpart = u.pn >> 2, h = u.pn & 3; const float sc = kpart ? 0.0625f : 1.0f;
#pragma unroll
        for (int ai = 0; ai < 2; ++ai) {
            f32x4 tb[4][4];
#pragma unroll
            for (int m = 0; m < 4; ++m) {
                const int row = rowb + ai * HALF + m * 16;
                const f32x4* tp = (const f32x4*)(J.f0 + ((size_t)row * 128 + colb) * 2);
                tb[m][0] = tp[0]; tb[m][1] = tp[1]; tb[m][2] = tp[2]; tb[m][3] = tp[3];
            }
#pragma unroll
            for (int m = 0; m < 4; ++m) {
                const int row = rowb + ai * HALF + m * 16; const int b = row >> 11, s = row & 2047;
                bf16_t* dst = J.out + ((size_t)(b * 2 + kpart) * 2048 + s) * 1024 + h * 256 + colb;
                const f32x4 t0 = tb[m][0], t1 = tb[m][1], t2 = tb[m][2], t3 = tb[m][3];
                const f32x4 a0 = acc[ai][0][m][0], a1 = acc[ai][0][m][1], b0 = acc[ai][1][m][0], b1 = acc[ai][1][m][1];
                f32x4 o0, o1, p0, p1;
                o0[0] = (a0[0] * t0[0] - b0[0] * t0[1]) * sc; p0[0] = (a0[0] * t0[1] + b0[0] * t0[0]) * sc;
                o0[1] = (a0[1] * t0[2] - b0[1] * t0[3]) * sc; p0[1] = (a0[1] * t0[3] + b0[1] * t0[2]) * sc;
                o0[2] = (a0[2] * t1[0] - b0[2] * t1[1]) * sc; p0[2] = (a0[2] * t1[1] + b0[2] * t1[0]) * sc;
                o0[3] = (a0[3] * t1[2] - b0[3] * t1[3]) * sc; p0[3] = (a0[3] * t1[3] + b0[3] * t1[2]) * sc;
                o1[0] = (a1[0] * t2[0] - b1[0] * t2[1]) * sc; p1[0] = (a1[0] * t2[1] + b1[0] * t2[0]) * sc;
                o1[1] = (a1[1] * t2[2] - b1[1] * t2[3]) * sc; p1[1] = (a1[1] * t2[3] + b1[1] * t2[2]) * sc;
                o1[2] = (a1[2] * t3[0] - b1[2] * t3[1]) * sc; p1[2] = (a1[2] * t3[1] + b1[2] * t3[0]) * sc;
                o1[3] = (a1[3] * t3[2] - b1[3] * t3[3]) * sc; p1[3] = (a1[3] * t3[3] + b1[3] * t3[2]) * sc;
                *(u32x4*)dst = pack8(o0, o1); *(u32x4*)(dst + 128) = pack8(p0, p1);
            }
            EPI_FENCE();
        }
    } break;
    case EPI_STORE: case EPI_RELU2: { if (!((EPI_MASK >> EPI_STORE) & 1)) break;
        if (var == 0) { J.out = (bf16_t*)(ws + WS_R2); J.ldc = 2048; J.zC = (long)2048 * 2048; } else if (var == 1) { J.out = (bf16_t*)(ws + WS_R3); J.ldc = 1024; } else if (var == 2) { J.out = (bf16_t*)(ws + WS_R1); J.ldc = 1024; } else { J.out = (bf16_t*)(ws + WS_R1); J.ldc = 4096; }
        bf16_t* base = J.out + (size_t)(u.z & 15) * J.zC + u.pn * BM + colb;
#pragma unroll
        for (int ai = 0; ai < 2; ++ai)
#pragma unroll
            for (int m = 0; m < 4; ++m) {
                bf16_t* rowp = base + (size_t)(rowb + ai * HALF + m * 16) * J.ldc;
#pragma unroll
                for (int bj = 0; bj < 2; ++bj) {
                    f32x4 v0 = acc[ai][bj][m][0], v1 = acc[ai][bj][m][1];
                    if (epi == EPI_RELU2) {
#pragma unroll
                        for (int i = 0; i < 4; ++i) { const float x0 = fmaxf(v0[i], 0.f), x1 = fmaxf(v1[i], 0.f); v0[i] = x0 * x0; v1[i] = x1 * x1; }
                    }
                    if (epi == EPI_RELU2) __builtin_nontemporal_store(pack8(v0, v1), (u32x4*)(rowp + bj * HALF));
                    else *(u32x4*)(rowp + bj * HALF) = pack8(v0, v1);
                }
            }
    } break;
    case EPI_SDECAY: { if (!((EPI_MASK >> EPI_SDECAY) & 1)) break;
        J.out = (u.z >= 16) ? (bf16_t*)ap->out : (bf16_t*)(ws + WS_R3); J.ldc = 2048; J.zC = (long)2048 * 2048; J.f0 = (const float*)(ws + WS_DEC);
        const int h = u.z & 3;
        const float lf = J.f0[h], lb = J.f0[4 + h];
        bf16_t* base = J.out + (size_t)(u.z & 15) * J.zC + u.pn * BM + colb;
        if (u.pm == u.pn) {
#pragma unroll
            for (int ai = 0; ai < 2; ++ai)
#pragma unroll
                for (int m = 0; m < 4; ++m) {
                    const int row = rowb + ai * HALF + m * 16;
                    bf16_t* rowp = base + (size_t)row * J.ldc;
#pragma unroll
                    for (int bj = 0; bj < 2; ++bj) {
                        const int col = u.pn * BM + bj * HALF + colb;
                        f32x4 v0 = acc[ai][bj][m][0], v1 = acc[ai][bj][m][1];
#pragma unroll
                        for (int i = 0; i < 4; ++i) {
                            const int d0 = row - (col + i), d1 = row - (col + 4 + i);
                            v0[i] *= __builtin_amdgcn_exp2f(d0 >= 0 ? lf * (float)d0 : lb * (float)(-d0));
                            v1[i] *= __builtin_amdgcn_exp2f(d1 >= 0 ? lf * (float)d1 : lb * (float)(-d1));
                        }
                        *(u32x4*)(rowp + bj * HALF) = pack8(v0, v1);
                    }
                }
        } else {
            const bool below = u.pm > u.pn; const int R0 = u.pm * BM, C0 = u.pn * BM; const float lg = below ? lf : lb;
            f32x4 cf[2][2];
#pragma unroll
            for (int bj = 0; bj < 2; ++bj)
#pragma unroll
                for (int n = 0; n < 2; ++n)
#pragma unroll
                    for (int i = 0; i < 4; ++i) { const int col = C0 + bj * HALF + colb + 4 * n + i; cf[bj][n][i] = __builtin_amdgcn_exp2f(lg * (float)(below ? (R0 - col) : (col - C0))); }
#pragma unroll
            for (int ai = 0; ai < 2; ++ai)
#pragma unroll
                for (int m = 0; m < 4; ++m) {
                    const int row = rowb + ai * HALF + m * 16;
                    const float rf = __builtin_amdgcn_exp2f(lg * (float)(below ? (row - R0) : (C0 - row)));
                    bf16_t* rowp = base + (size_t)row * J.ldc;
#pragma unroll
                    for (int bj = 0; bj < 2; ++bj)
                        *(u32x4*)(rowp + bj * HALF) = pack8(acc[ai][bj][m][0] * (cf[bj][0] * rf), acc[ai][bj][m][1] * (cf[bj][1] * rf));
                }
        }
    } break;
    case EPI_OY: { if (!((EPI_MASK >> EPI_OY) & 1)) break;
        J.out = (bf16_t*)(ws + WS_R1); J.s0 = (float*)(ws + WS_GN);
        const int b = var + (u.z >> 2), h = u.z & 3;
#pragma unroll
        for (int ai = 0; ai < 2; ++ai)
#pragma unroll
            for (int m = 0; m < 4; ++m) {
                const int row = rowb + ai * HALF + m * 16; const size_t tok = (size_t)b * 2048 + row;
                bf16_t* rowp = J.out + tok * 2048 + h * 512 + u.pn * BM + colb;
                float s1 = 0.f, s2 = 0.f;
#pragma unroll
                for (int bj = 0; bj < 2; ++bj) {
                    const f32x4 v0 = acc[ai][bj][m][0], v1 = acc[ai][bj][m][1];
#pragma unroll
                    for (int i = 0; i < 4; ++i) { s1 += v0[i] + v1[i]; s2 += v0[i] * v0[i] + v1[i] * v1[i]; }
                    *(u32x4*)(rowp + bj * HALF) = pack8(v0, v1);
                }
                s1 += __shfl_xor(s1, 16); s1 += __shfl_xor(s1, 32); s2 += __shfl_xor(s2, 16); s2 += __shfl_xor(s2, 32);
                if (fq == 0) { float* g = J.s0 + (tok * 4 + h) * 2; atomicAdd(g, s1); atomicAdd(g + 1, s2); }
                EPI_FENCE();
            }
    } break;
    case EPI_GATE: { if (!((EPI_MASK >> EPI_GATE) & 1)) break;
        J.out = (bf16_t*)(ws + WS_R1); J.f0 = (const float*)(ws + WS_GN); J.f1 = ap->in[9];
        const int h = u.pn >> 1;
        f32x4 gw[2][2];
#pragma unroll
        for (int bj = 0; bj < 2; ++bj)
#pragma unroll
            for (int n = 0; n < 2; ++n) gw[bj][n] = *(const f32x4*)(J.f1 + u.pn * BM + bj * HALF + colb + 4 * n);
#pragma unroll
        for (int ai = 0; ai < 2; ++ai) {
            f32x2 st[4]; u32x4 yv[4][2];
#pragma unroll
            for (int m = 0; m < 4; ++m) {
                const size_t tok = (size_t)(rowb + ai * HALF + m * 16);
                st[m] = *(const f32x2*)(J.f0 + (tok * 4 + h) * 2);
                const bf16_t* rowp = J.out + tok * 2048 + u.pn * BM + colb;
                yv[m][0] = *(const u32x4*)(rowp); yv[m][1] = *(const u32x4*)(rowp + HALF);
            }
#pragma unroll
            for (int m = 0; m < 4; ++m) {
                const size_t tok = (size_t)(rowb + ai * HALF + m * 16);
                const float mu = st[m][0] * (1.0f / 512.0f); const float var = st[m][1] * (1.0f / 512.0f) - mu * mu;
                const float rstd = 1.0f / sqrtf(fmaxf(var, 0.f) + 1e-5f);
                bf16_t* rowp = J.out + tok * 2048 + u.pn * BM + colb;
#pragma unroll
                for (int bj = 0; bj < 2; ++bj) {
                    const u32x4 yw = yv[m][bj];
                    const f32x4 a0 = acc[ai][bj][m][0], a1 = acc[ai][bj][m][1];
                    f32x4 y0, y1, o0, o1;
                    y0[0] = bf2f(yw.x & 0xffffu); y0[1] = bf2f(yw.x >> 16); y0[2] = bf2f(yw.y & 0xffffu); y0[3] = bf2f(yw.y >> 16);
                    y1[0] = bf2f(yw.z & 0xffffu); y1[1] = bf2f(yw.z >> 16); y1[2] = bf2f(yw.w & 0xffffu); y1[3] = bf2f(yw.w >> 16);
#pragma unroll
                    for (int i = 0; i < 4; ++i) {
                        const float sg0 = a0[i] * __builtin_amdgcn_rcpf(1.0f + __expf(-a0[i])), sg1 = a1[i] * __builtin_amdgcn_rcpf(1.0f + __expf(-a1[i]));
                        o0[i] = sg0 * ((y0[i] - mu) * rstd * gw[bj][0][i]); o1[i] = sg1 * ((y1[i] - mu) * rstd * gw[bj][1][i]);
                    }
                    *(u32x4*)(rowp + bj * HALF) = pack8(o0, o1);
                }
            }
            EPI_FENCE();
        }
    } break;
    case EPI_WIN: { if (!((EPI_MASK >> EPI_WIN) & 1)) break;
        J.out = (bf16_t*)(ws + WS_R3); J.s0 = (float*)(ws + WS_SSQQ); J.s1 = (float*)(ws + WS_SSQKV);
#pragma unroll
        for (int ai = 0; ai < 2; ++ai)
#pragma unroll
            for (int m = 0; m < 4; ++m) {
                const int row = rowb + ai * HALF + m * 16;
                bf16_t* rowp = J.out + (size_t)row * 768 + u.pn * BM + colb;
                float sq = 0.f, skv = 0.f;
#pragma unroll
                for (int bj = 0; bj < 2; ++bj) {
                    const f32x4 v0 = acc[ai][bj][m][0], v1 = acc[ai][bj][m][1];
                    float s = 0.f;
#pragma unroll
                    for (int i = 0; i < 4; ++i) s += v0[i] * v0[i] + v1[i] * v1[i];
                    const int reg = u.pn * 2 + bj;
                    if (reg < 3) sq += s; else if (reg < 5) skv += s;
                    *(u32x4*)(rowp + bj * HALF) = pack8(v0, v1);
                }
                sq += __shfl_xor(sq, 16); sq += __shfl_xor(sq, 32); skv += __shfl_xor(skv, 16); skv += __shfl_xor(skv, 32);
                if (fq == 0) { if (u.pn < 2) atomicAdd(J.s0 + row, sq); if (u.pn > 0) atomicAdd(J.s1 + row, skv); }
                EPI_FENCE();
            }
    } break;
    case EPI_UQ: { if (!((EPI_MASK >> EPI_UQ) & 1)) break;
        J.out = (bf16_t*)(ws + WS_R1); J.f0 = (const float*)(ws + WS_SSQQ); J.f1 = (const float*)(ws + WS_R3 + 64 * MiB);
#pragma unroll
        for (int ai = 0; ai < 2; ++ai)
#pragma unroll
            for (int m = 0; m < 4; ++m) {
                const int row = rowb + ai * HALF + m * 16;
                const float rstd = 1.0f / sqrtf(J.f0[row] * (1.0f / 384.0f) + 1e-6f);
                bf16_t* qrow = J.out + (size_t)row * 1536;
                if (u.pn < 4) {
#pragma unroll
                    for (int bj = 0; bj < 2; ++bj) {
                        const int hd = u.pn * 2 + bj;
                        *(u32x4*)(qrow + hd * 192 + colb) = pack8(acc[ai][bj][m][0] * rstd, acc[ai][bj][m][1] * rstd);
                    }
                } else {
                    const int hd = (u.pn - 4) * 4 + wc; const int j0 = 8 * fq;
                    const f32x4* tp = (const f32x4*)(J.f1 + ((size_t)row * 32 + j0) * 2);
                    const f32x4 t0 = tp[0], t1 = tp[1], t2 = tp[2], t3 = tp[3];
                    const f32x4 a0 = acc[ai][0][m][0] * rstd, a1 = acc[ai][0][m][1] * rstd, b0 = acc[ai][1][m][0] * rstd, b1 = acc[ai][1][m][1] * rstd;
                    f32x4 o0, o1, p0, p1;
                    o0[0] = a0[0] * t0[0] - b0[0] * t0[1]; p0[0] = a0[0] * t0[1] + b0[0] * t0[0];
                    o0[1] = a0[1] * t0[2] - b0[1] * t0[3]; p0[1] = a0[1] * t0[3] + b0[1] * t0[2];
                    o0[2] = a0[2] * t1[0] - b0[2] * t1[1]; p0[2] = a0[2] * t1[1] + b0[2] * t1[0];
                    o0[3] = a0[3] * t1[2] - b0[3] * t1[3]; p0[3] = a0[3] * t1[3] + b0[3] * t1[2];
                    o1[0] = a1[0] * t2[0] - b1[0] * t2[1]; p1[0] = a1[0] * t2[1] + b1[0] * t2[0];
                    o1[1] = a1[1] * t2[2] - b1[1] * t2[3]; p1[1] = a1[1] * t2[3] + b1[1] * t2[2];
                    o1[2] = a1[2] * t3[0] - b1[2] * t3[1]; p1[2] = a1[2] * t3[1] + b1[2] * t3[0];
                    o1[3] = a1[3] * t3[2] - b1[3] * t3[3]; p1[3] = a1[3] * t3[3] + b1[3] * t3[2];
                    *(u32x4*)(qrow + hd * 192 + 128 + j0) = pack8(o0, o1); *(u32x4*)(qrow + hd * 192 + 160 + j0) = pack8(p0, p1);
                }
                EPI_FENCE();
            }
    } break;
    case EPI_UKV: { if (!((EPI_MASK >> EPI_UKV) & 1)) break;
        J.out = (bf16_t*)(ws + WS_R1) + (size_t)T_TOK * 1536; J.out2 = (bf16_t*)(ws + WS_R1) + (size_t)2 * T_TOK * 1536; J.f0 = (const float*)(ws + WS_SSQKV); J.f1 = (const float*)(ws + WS_R3 + 64 * MiB); J.b0 = (bf16_t*)(ws + WS_R3);
        const int hd = u.pn;
#pragma unroll
        for (int ai = 0; ai < 2; ++ai)
#pragma unroll
            for (int m = 0; m < 4; ++m) {
                const int row = rowb + ai * HALF + m * 16;
                const float rstd = 1.0f / sqrtf(J.f0[row] * (1.0f / 256.0f) + 1e-6f);
                bf16_t* krow = J.out + (size_t)row * 1536 + hd * 192;
                *(u32x4*)(krow + colb) = pack8(acc[ai][0][m][0] * rstd, acc[ai][0][m][1] * rstd);
                *(u32x4*)(J.out2 + (size_t)row * 1024 + hd * 128 + colb) = pack8(acc[ai][1][m][0] * rstd, acc[ai][1][m][1] * rstd);
                const int j = wc * 8 + fq * 2;
                const unsigned c1 = *(const unsigned*)(J.b0 + (size_t)row * 768 + 640 + j), c2 = *(const unsigned*)(J.b0 + (size_t)row * 768 + 672 + j);
                const f32x4 t = *(const f32x4*)(J.f1 + ((size_t)row * 32 + j) * 2);
                const float x0 = bf2f(c1 & 0xffffu), x1 = bf2f(c1 >> 16), y0 = bf2f(c2 & 0xffffu), y1 = bf2f(c2 >> 16);
                *(unsigned*)(krow + 128 + j) = cvt_pk_bf16(x0 * t[0] - y0 * t[1], x1 * t[2] - y1 * t[3]);
                *(unsigned*)(krow + 160 + j) = cvt_pk_bf16(x0 * t[1] + y0 * t[0], x1 * t[3] + y1 * t[2]);
                EPI_FENCE();
            }
    } break;
    default: break;
    }
}

__device__ __forceinline__ void gemm_phase(LAS unsigned char* lds, const GemmJob& g, const Sched& S, ArgsP ap, const int tid_in) {
    int tid = threadIdx.x; asm volatile("" : "+v"(tid)); (void)tid_in;
    const int wid = __builtin_amdgcn_readfirstlane(tid >> 6), lane = tid & 63, wr = wid >> 2, wc = wid & 3, fr = lane & 15, fq = lane >> 4;
    const int nt = g.K / BK;
    unsigned voffA[2], voffB[2];
#pragma unroll
    for (int i = 0; i < 2; ++i) { int R, C; stage_rc(tid * 16 + i * 8192, R, C); const int Rb = (R & ~31) + perm32(R & 31);
        voffA[i] = (unsigned)(R * g.lda + C) * 2u; voffB[i] = (unsigned)(Rb * g.ldb + C) * 2u; }
    const size_t kstep = (size_t)(BK * 2);
    const size_t hstepA = (size_t)HALF * g.lda * 2, hstepB = (size_t)HALF * g.ldb * 2;
    const unsigned ldsw = (unsigned)wid * 1024u;
    const int aoff = lds_byte(wr * 64 + fr, fq * 8), boff = lds_byte(wc * 32 + fr, fq * 8);
#define PG8_SA(b, h) (((b) * 2 + (h)) * HTB)
#define PG8_SB(b, h) ((4 + (b) * 2 + (h)) * HTB)
#define PG8_STAGE(bufoff, gbase, voff) do { _Pragma("unroll") for (int _i = 0; _i < 2; ++_i) \
        __builtin_amdgcn_global_load_lds((const unsigned*)((const char*)(gbase) + (voff)[_i]), (LAS unsigned*)(lds + (bufoff) + ldsw + _i * 8192), 16, 0, 0); } while (0)
#define PG8_LDA(dst, b, h) do { _Pragma("unroll") for (int m = 0; m < 4; ++m) _Pragma("unroll") for (int k = 0; k < 2; ++k) dst[m][k] = *(const LAS bf16x8*)(lds + PG8_SA(b, h) + aoff + m * 2048 + k * 1024); } while (0)
#define PG8_LDB(dst, b, h) do { _Pragma("unroll") for (int n = 0; n < 2; ++n) _Pragma("unroll") for (int k = 0; k < 2; ++k) dst[n][k] = *(const LAS bf16x8*)(lds + PG8_SB(b, h) + boff + n * 2048 + k * 1024); } while (0)
#define PG8_MMA(ai, bj, At, Bt) do { __builtin_amdgcn_s_setprio(1); _Pragma("unroll") for (int m = 0; m < 4; ++m) _Pragma("unroll") for (int n = 0; n < 2; ++n) _Pragma("unroll") for (int k = 0; k < 2; ++k) \
        acc[ai][bj][m][n] = __builtin_amdgcn_mfma_f32_16x16x32_bf16(Bt[n][k], At[m][k], acc[ai][bj][m][n], 0, 0, 0); __builtin_amdgcn_s_setprio(0); } while (0)
#define PG8_WAIT_V(n) asm volatile("s_waitcnt vmcnt(" #n ")" ::: "memory")
#define PG8_WAIT_L(n) asm volatile("s_waitcnt lgkmcnt(" #n ")" ::: "memory")
#define PG8_BAR __builtin_amdgcn_s_barrier()
#define PG8_SCHED __builtin_amdgcn_sched_barrier(0)
#define PG8_PTRA(u) ((const char*)g.A + 2 * ((size_t)((u).z / g.zdiv) * g.zAh + (size_t)((u).z % g.zdiv) * g.zAl + (size_t)(u).pm * BM * g.lda))
#define PG8_PTRB(u) ((const char*)g.Bt + 2 * ((size_t)((u).z / g.zdiv) * g.zBh + (size_t)((u).z % g.zdiv) * g.zBl + (size_t)(u).pn * BM * g.ldb))
    Unit cur, nxt; int ui = 0;
    if (!S.next(0, cur)) return;
    Acc acc;
#pragma unroll
    for (int a = 0; a < 2; ++a)
#pragma unroll
        for (int b = 0; b < 2; ++b)
#pragma unroll
            for (int m = 0; m < 4; ++m)
#pragma unroll
                for (int n = 0; n < 2; ++n) acc[a][b][m][n] = (f32x4){0.f, 0.f, 0.f, 0.f};
    bf16x8 At[4][2], B0[2][2], B1[2][2];
    const char* cA = PG8_PTRA(cur); const char* cB = PG8_PTRB(cur);
    PG8_STAGE(PG8_SB(0, 0), cB, voffB); PG8_STAGE(PG8_SB(0, 1), cB + hstepB, voffB); PG8_STAGE(PG8_SA(0, 0), cA, voffA); PG8_STAGE(PG8_SA(0, 1), cA + hstepA, voffA);
    if (wr == 1) PG8_BAR;
    PG8_WAIT_V(2); PG8_BAR;
    PG8_STAGE(PG8_SB(1, 0), cB + kstep, voffB); PG8_STAGE(PG8_SA(1, 0), cA + kstep, voffA); PG8_STAGE(PG8_SB(1, 1), cB + hstepB + kstep, voffB);
    PG8_WAIT_V(6); PG8_BAR;
    for (;;) {
        const bool has_next = S.next(ui + 1, nxt);
        const char* nA = cA; const char* nB = cB;
        if (has_next) { nA = PG8_PTRA(nxt); nB = PG8_PTRB(nxt); }
        for (int t = 0; t < nt; t += 2) {
            const bool last = (t == nt - 2);
            const char* a1 = cA + (size_t)(t + 1) * kstep;
            const char* a2 = last ? nA : cA + (size_t)(t + 2) * kstep; const char* b2 = last ? nB : cB + (size_t)(t + 2) * kstep;
            const char* a3 = a2 + kstep; const char* b3 = b2 + kstep;
            PG8_LDB(B0, 0, 0); PG8_LDB(B1, 0, 1); PG8_SCHED; PG8_LDA(At, 0, 0); PG8_STAGE(PG8_SA(1, 1), a1 + hstepA, voffA);
            PG8_WAIT_V(8); PG8_WAIT_L(0); PG8_BAR; PG8_MMA(0, 0, At, B0); PG8_MMA(0, 1, At, B1); PG8_BAR; PG8_SCHED;
            PG8_LDA(At, 0, 1); PG8_STAGE(PG8_SB(0, 0), b2, voffB); PG8_STAGE(PG8_SB(0, 1), b2 + hstepB, voffB); PG8_STAGE(PG8_SA(0, 0), a2, voffA);
            PG8_WAIT_V(8); PG8_WAIT_L(0); PG8_BAR; PG8_MMA(1, 0, At, B0); PG8_MMA(1, 1, At, B1); PG8_BAR; PG8_SCHED;
            PG8_LDB(B0, 1, 0); PG8_LDB(B1, 1, 1); PG8_SCHED; PG8_LDA(At, 1, 0); PG8_STAGE(PG8_SA(0, 1), a2 + hstepA, voffA);
            PG8_WAIT_V(8); PG8_WAIT_L(0); PG8_BAR; PG8_MMA(0, 0, At, B0); PG8_MMA(0, 1, At, B1); PG8_BAR; PG8_SCHED;
            PG8_LDA(At, 1, 1); PG8_STAGE(PG8_SB(1, 0), b3, voffB); PG8_STAGE(PG8_SB(1, 1), b3 + hstepB, voffB); PG8_STAGE(PG8_SA(1, 0), a3, voffA);
            PG8_WAIT_V(8); PG8_WAIT_L(0); PG8_BAR; PG8_MMA(1, 0, At, B0); PG8_MMA(1, 1, At, B1); PG8_BAR; PG8_SCHED;
        }
        if (wr == 0) PG8_BAR;
        epilogue(acc, cur, wr, wc, fr, fq, g.epi, g.var, ap);
        if (!has_next) break;
#pragma unroll
        for (int a = 0; a < 2; ++a)
#pragma unroll
            for (int b = 0; b < 2; ++b)
#pragma unroll
                for (int m = 0; m < 4; ++m)
#pragma unroll
                    for (int n = 0; n < 2; ++n) acc[a][b][m][n] = (f32x4){0.f, 0.f, 0.f, 0.f};
        cur = nxt; cA = nA; cB = nB; ++ui;
        if (wr == 1) PG8_BAR;
    }
    PG8_WAIT_V(0);
    PG8_BAR;
#undef PG8_SA
#undef PG8_SB
#undef PG8_STAGE
#undef PG8_LDA
#undef PG8_LDB
#undef PG8_MMA
#undef PG8_WAIT_V
#undef PG8_WAIT_L
#undef PG8_BAR
#undef PG8_SCHED
#undef PG8_PTRA
#undef PG8_PTRB
}

namespace mla {
constexpr int LDQ = 1536, LDK = 1536, LDV = 1024, LDO = 1024;
constexpr int KT_BYTES = 64 * 192 * 2, VT_BYTES = 64 * 128 * 2;
constexpr int V_OFF = 0, K_OFF = 2 * VT_BYTES, WS_OFF = K_OFF + 2 * KT_BYTES;
constexpr float SCALE = 0.07216878364870322f;
constexpr float THR = 8.f;
#define KSWZ(row, colB) ((row) * 384 + ((colB) ^ (((row) & 7) << 4)))
#define SBAR() __builtin_amdgcn_sched_barrier(0)
__device__ __forceinline__ int crow(int r, int hi) { return (r & 3) + 8 * (r >> 2) + 4 * hi; }
__device__ __forceinline__ void partialSM(f32x16& p0, f32x16& p1, float& m_reg, float& mn, float& alpha) {
    constexpr float C = SCALE * 1.4426950408889634f;
    float pmax = p0[0];
#pragma unroll
    for (int r = 1; r < 16; ++r) pmax = fmaxf(pmax, p0[r]);
#pragma unroll
    for (int r = 0; r < 16; ++r) pmax = fmaxf(pmax, p1[r]);
    { auto rr = __builtin_amdgcn_permlane32_swap(__float_as_uint(pmax), __float_as_uint(pmax), false, false);
      pmax = fmaxf(__uint_as_float(rr[0]), __uint_as_float(rr[1])); }
    if (__builtin_expect(__all(pmax - m_reg <= THR / SCALE), 1)) { mn = m_reg; alpha = 1.f; }
    else { mn = fmaxf(m_reg, pmax); alpha = __builtin_amdgcn_exp2f((m_reg - mn) * C); m_reg = mn; }
    const float mnC = -mn * C;
#pragma unroll
    for (int r = 0; r < 16; ++r) p0[r] = __builtin_amdgcn_exp2f(fmaf(p0[r], C, mnC));
#pragma unroll
    for (int r = 0; r < 16; ++r) p1[r] = __builtin_amdgcn_exp2f(fmaf(p1[r], C, mnC));
}
__device__ __forceinline__ void finishSM(f32x16& p0, f32x16& p1, float alpha, float& l_reg, bf16x8& pa0, bf16x8& pa1, bf16x8& pa2, bf16x8& pa3) {
    float ps = 0;
#pragma unroll
    for (int r = 0; r < 16; ++r) ps += p0[r];
#pragma unroll
    for (int r = 0; r < 16; ++r) ps += p1[r];
    { auto rr = __builtin_amdgcn_permlane32_swap(__float_as_uint(ps), __float_as_uint(ps), false, false);
      ps = __uint_as_float(rr[0]) + __uint_as_float(rr[1]); }
    l_reg = l_reg * alpha + ps;
#define PK4(P, BASE, OUT) do { unsigned a0 = cvt_pk_bf16(P[BASE + 0], P[BASE + 1]), a1 = cvt_pk_bf16(P[BASE + 2], P[BASE + 3]);   \
    unsigned b0 = cvt_pk_bf16(P[BASE + 4], P[BASE + 5]), b1 = cvt_pk_bf16(P[BASE + 6], P[BASE + 7]);                              \
    auto r0 = __builtin_amdgcn_permlane32_swap(a0, b0, false, false); auto r1 = __builtin_amdgcn_permlane32_swap(a1, b1, false, false); \
    u32x4 w = {r0[0], r1[0], r0[1], r1[1]}; OUT = *reinterpret_cast<bf16x8*>(&w); } while (0)
    PK4(p0, 0, pa0); PK4(p0, 8, pa1); PK4(p1, 0, pa2); PK4(p1, 8, pa3);
#undef PK4
}
__device__ __forceinline__ int v_st(int k, int c) { const int kk = (k & ~0xC) | ((k & 4) << 1) | ((k & 8) >> 1); return ((kk >> 3) * 4 + (c >> 5)) * 512 + ((kk & 7) * 32 + (c & 31)) * 2; }
__device__ __forceinline__ int v_rd_base(int lane) { return ((lane & 3) << 3) | (((lane >> 2) & 3) << 6) | (((lane >> 4) & 1) << 5) | (((lane >> 5) & 1) << 8); }
constexpr int v_rd_off(int d0, int ks, int half) { return d0 * 512 + ks * 4096 + half * 2048; }
template <int OFF> __device__ __forceinline__ s16x4 tr_read(int vb) {
    s16x4 r; asm volatile("ds_read_b64_tr_b16 %0, %1 offset:%2" : "=&v"(r) : "v"(vb), "i"(OFF) : "memory"); return r;
}
template <int D0> __device__ __forceinline__ void pv_one(f32x16& od, int vb, bf16x8 pa0, bf16x8 pa1, bf16x8 pa2, bf16x8 pa3) {
    const s16x4 l0 = tr_read<v_rd_off(D0, 0, 0)>(vb), h0 = tr_read<v_rd_off(D0, 0, 1)>(vb), l1 = tr_read<v_rd_off(D0, 1, 0)>(vb), h1 = tr_read<v_rd_off(D0, 1, 1)>(vb);
    const s16x4 l2 = tr_read<v_rd_off(D0, 2, 0)>(vb), h2 = tr_read<v_rd_off(D0, 2, 1)>(vb), l3 = tr_read<v_rd_off(D0, 3, 0)>(vb), h3 = tr_read<v_rd_off(D0, 3, 1)>(vb);
    asm volatile("s_waitcnt lgkmcnt(0)" ::: "memory"); SBAR();
#define PK(L, H) (bf16x8){L[0], L[1], L[2], L[3], H[0], H[1], H[2], H[3]}
    od = __builtin_amdgcn_mfma_f32_32x32x16_bf16(pa0, PK(l0, h0), od, 0, 0, 0);
    od = __builtin_amdgcn_mfma_f32_32x32x16_bf16(pa1, PK(l1, h1), od, 0, 0, 0);
    od = __builtin_amdgcn_mfma_f32_32x32x16_bf16(pa2, PK(l2, h2), od, 0, 0, 0);
    od = __builtin_amdgcn_mfma_f32_32x32x16_bf16(pa3, PK(l3, h3), od, 0, 0, 0);
#undef PK
}
__device__ __forceinline__ void attn_unit(const bf16_t* __restrict__ Qb, const bf16_t* __restrict__ Kh, const bf16_t* __restrict__ Vh, bf16_t* __restrict__ Ob, char* lds, const int tid_in) {
    int tid = threadIdx.x; asm volatile("" : "+v"(tid)); (void)tid_in;
    const int wid = tid >> 6, lane = tid & 63, r32 = lane & 31, hi = lane >> 5;
    char* V_lds = lds + V_OFF; char* K_lds = lds + K_OFF;
    float* ws = (float*)(lds + WS_OFF) + wid * 64; float* li_l = ws; float* al_l = ws + 32;
    float m_reg = -1e30f, l_reg = 0; f32x16 o0 = {}, o1 = {}, o2 = {}, o3 = {}; bf16x8 qr[12];
    const bf16_t* Qw = Qb + (size_t)(wid * 32 + r32) * LDQ + hi * 8;
#pragma unroll
    for (int d0 = 0; d0 < 12; ++d0) qr[d0] = *(const bf16x8*)(Qw + d0 * 16);
    LAS unsigned char* ldsl = (LAS unsigned char*)lds;
    unsigned kof[3], vof[2];
#pragma unroll
    for (int i = 0; i < 3; ++i) { const int p = (i * 8 + wid) * 64 + lane, row = p / 24, chs = p % 24, ch = (chs & ~7) | ((chs ^ row) & 7); kof[i] = (unsigned)(row * LDK + ch * 8) * 2u; }
#pragma unroll
    for (int i = 0; i < 2; ++i) { const int p = (i * 8 + wid) * 64 + lane, sub = p >> 5, kkh = sub >> 2, chh = sub & 3, kkl = (p & 31) >> 2, cl = (p & 3) * 8;
        const int kk = kkh * 8 + kkl, k = (kk & ~0xC) | ((kk & 4) << 1) | ((kk & 8) >> 1), c = chh * 32 + cl; vof[i] = (unsigned)(k * LDV + c) * 2u; }
    const int vb0 = (int)(uintptr_t)V_lds + v_rd_base(lane);
    const int wofs = __builtin_amdgcn_readfirstlane(wid) * 1024;
#define SDMA(k0, b) do { \
    _Pragma("unroll") for (int _i = 0; _i < 3; ++_i) __builtin_amdgcn_global_load_lds((const unsigned*)((const char*)Kh + (size_t)(k0) * LDK * 2 + kof[_i]), (LAS unsigned*)(ldsl + K_OFF + (b) * KT_BYTES + _i * 8192 + wofs), 16, 0, 0); \
    _Pragma("unroll") for (int _i = 0; _i < 2; ++_i) __builtin_amdgcn_global_load_lds((const unsigned*)((const char*)Vh + (size_t)(k0) * LDV * 2 + vof[_i]), (LAS unsigned*)(ldsl + V_OFF + (b) * VT_BYTES + _i * 8192 + wofs), 16, 0, 0); } while (0)
    constexpr int NT = SEQ / 64;
    SDMA(0, 0); asm volatile("s_waitcnt vmcnt(0)" ::: "memory"); __syncthreads();
    for (int j = 0; j < NT; ++j) {
        const int cur = j & 1;
        if (j + 1 < NT) SDMA((j + 1) * 64, cur ^ 1);
        f32x16 p0 = {}, p1 = {};
        const char* Ks = K_lds + cur * KT_BYTES;
#pragma unroll
        for (int d0 = 0; d0 < 12; ++d0) { const int cb = (d0 * 16 + hi * 8) * 2;
            const bf16x8 b0 = *(const bf16x8*)(Ks + KSWZ(r32, cb));
            const bf16x8 b1 = *(const bf16x8*)(Ks + KSWZ(32 + r32, cb));
            p0 = __builtin_amdgcn_mfma_f32_32x32x16_bf16(b0, qr[d0], p0, 0, 0, 0);
            p1 = __builtin_amdgcn_mfma_f32_32x32x16_bf16(b1, qr[d0], p1, 0, 0, 0); }
        float mn, alpha; bf16x8 pa0, pa1, pa2, pa3;
        partialSM(p0, p1, m_reg, mn, alpha);
        if (__any(alpha < 1.f)) { if (hi == 0) al_l[r32] = alpha; asm volatile("s_waitcnt lgkmcnt(0)" ::: "memory");
#pragma unroll
            for (int r = 0; r < 16; ++r) { const float a = al_l[crow(r, hi)]; o0[r] *= a; o1[r] *= a; o2[r] *= a; o3[r] *= a; } }
        finishSM(p0, p1, alpha, l_reg, pa0, pa1, pa2, pa3);
        const int vb = vb0 + cur * VT_BYTES;
        pv_one<0>(o0, vb, pa0, pa1, pa2, pa3); pv_one<1>(o1, vb, pa0, pa1, pa2, pa3); pv_one<2>(o2, vb, pa0, pa1, pa2, pa3); pv_one<3>(o3, vb, pa0, pa1, pa2, pa3);
        asm volatile("s_waitcnt vmcnt(0)" ::: "memory");
        __syncthreads();
    }
    if (hi == 0) li_l[r32] = l_reg; asm volatile("s_waitcnt lgkmcnt(0)" ::: "memory");
    bf16_t* Ow = Ob + (size_t)(wid * 32) * LDO;
#pragma unroll
    for (int r = 0; r < 16; ++r) { const int orow = crow(r, hi); const float rl = __builtin_amdgcn_rcpf(li_l[orow]);
        bf16_t* op = Ow + (size_t)orow * LDO + r32;
        op[0] = (bf16_t)(cvt_pk_bf16(o0[r] * rl, 0.f) & 0xffffu); op[32] = (bf16_t)(cvt_pk_bf16(o1[r] * rl, 0.f) & 0xffffu);
        op[64] = (bf16_t)(cvt_pk_bf16(o2[r] * rl, 0.f) & 0xffffu); op[96] = (bf16_t)(cvt_pk_bf16(o3[r] * rl, 0.f) & 0xffffu); }
    __syncthreads();
#undef SDMA
}
}


template <int MODE>
__device__ __forceinline__ void tr_item(const float* W, int K, int Nsrc, bf16_t* WT, int nrow0, int srccol0, bool zero, const float* kscale, int k0, LAS float* scr, int lane, float (&v)[32]) {
    if (MODE == 0) {
#pragma unroll
        for (int i = 0; i < 32; ++i) { const int kk = 2 * i + (lane >> 5);
            float x = 0.f; if (!zero) { x = __builtin_nontemporal_load(W + (size_t)(k0 + kk) * Nsrc + srccol0 + (lane & 31)); if (kscale) x *= kscale[k0 + kk]; }
            v[i] = x; }
    } else {
        const int c = lane & 7;
#pragma unroll
        for (int j = 0; j < 4; ++j) { const int n = (lane >> 3) + 8 * j; const LAS float* s = scr + (8 * c) * 33 + n;
            u32x4 o; o.x = cvt_pk_bf16(s[0 * 33], s[1 * 33]); o.y = cvt_pk_bf16(s[2 * 33], s[3 * 33]); o.z = cvt_pk_bf16(s[4 * 33], s[5 * 33]); o.w = cvt_pk_bf16(s[6 * 33], s[7 * 33]);
            *(u32x4*)(WT + (size_t)(nrow0 + n) * K + k0 + 8 * c) = o; }
        asm volatile("s_waitcnt lgkmcnt(0)" ::: "memory");
    }
}
template <int MODE>
__device__ __forceinline__ void tr_matrix_item(int it, ArgsP a, LAS float* scr, int lane, float (&v)[32]) {
    constexpr int C0 = 16 * 192, C1 = C0 + 32 * 32, C2 = C1 + 16 * 24, C3 = C2 + 6 * 48, C4 = C3 + 4 * 64, C5 = C4 + 16 * 32, C6 = C5 + 16 * 128, C7 = C6 + 16 * 128, C8 = C7 + 64 * 32;
    int item, id;
    if (it < C0) { id = 0; item = it; } else if (it < C1) { id = 1; item = it - C0; } else if (it < C2) { id = 2; item = it - C1; } else if (it < C3) { id = 3; item = it - C2; }
    else if (it < C4) { id = 4; item = it - C3; } else if (it < C5) { id = 5; item = it - C4; } else if (it < C6) { id = 6; item = it - C5; } else if (it < C7) { id = 7; item = it - C6; }
    else if (it < C8) { id = 8; item = it - C7; } else { id = 9; item = it - C8; }
    const float* W; int K, Nsrc, Ndst; bf16_t* WT; const float* ksc = nullptr;
    unsigned char* ws = a->ws;
    switch (id) {
    case 0: W = a->in[6]; K = 1024; Nsrc = 6144; Ndst = 6144; WT = (bf16_t*)(ws + WS_RWIN); break;
    case 1: W = a->in[10]; K = 2048; Nsrc = 1024; Ndst = 1024; WT = (bf16_t*)(ws + WS_RWOUT); break;
    case 2: W = a->in[11]; K = 1024; Nsrc = 704; Ndst = 768; WT = (bf16_t*)(ws + WS_MWIN); break;
    case 3: W = a->in[13]; K = 384; Nsrc = 1536; Ndst = 1536; WT = (bf16_t*)(ws + WS_MWUQ); ksc = a->in[12]; break;
    case 4: W = a->in[15]; K = 256; Nsrc = 2048; Ndst = 2048; WT = (bf16_t*)(ws + WS_MWUKV); ksc = a->in[14]; break;
    case 5: W = a->in[16]; K = 1024; Nsrc = 1024; Ndst = 1024; WT = (bf16_t*)(ws + WS_MWOUT); break;
    case 6: W = a->in[17]; K = 1024; Nsrc = 4096; Ndst = 4096; WT = (bf16_t*)(ws + WS_W1); break;
    case 7: W = a->in[17] + (size_t)1024 * 4096; K = 1024; Nsrc = 4096; Ndst = 4096; WT = (bf16_t*)(ws + WS_W1) + (size_t)4096 * 1024; break;
    case 8: W = a->in[18]; K = 4096; Nsrc = 1024; Ndst = 1024; WT = (bf16_t*)(ws + WS_W2); break;
    default: W = a->in[18] + (size_t)4096 * 1024; K = 4096; Nsrc = 1024; Ndst = 1024; WT = (bf16_t*)(ws + WS_W2) + (size_t)1024 * 4096; break;
    }
    const int nblk = Ndst / 32, kb = item / nblk, nb = item % nblk, n0 = nb * 32;
    int src0 = n0; bool zero = false;
    if (id == 2) zero = (n0 >= 704);
    if (id == 3) {
        if (n0 < 1024) { src0 = (n0 >> 7) * 192 + (n0 & 127); }
        else { const int r = n0 - 1024, t = r >> 8, cc = r & 255, half = cc >> 7, hh = (cc & 127) >> 5; src0 = (4 * t + hh) * 192 + 128 + half * 32; }
    }
    tr_item<MODE>(W, K, Nsrc, WT, n0, src0, zero, ksc, kb * 64, scr, lane, v);
}
__device__ __forceinline__ void prep_phase(ArgsP a, char* lds_g, int G, const int tid_in) {
    LAS unsigned char* lds = (LAS unsigned char*)lds_g;
    int tid = threadIdx.x; asm volatile("" : "+v"(tid)); (void)tid_in;
    const int lane = tid & 63, wave = tid >> 6;
    unsigned char* ws = a->ws;
    {
        LAS float* scr = (LAS float*)(lds + wave * 16384);
        const int gw = blockIdx.x * 8 + wave, NGW = G * 8;
        constexpr int C9 = 16 * 192 + 32 * 32 + 16 * 24 + 6 * 48 + 4 * 64 + 16 * 32 + 16 * 128 + 16 * 128 + 64 * 32 + 64 * 32;
        float v[32];
        int it = gw;
        if (it < C9) tr_matrix_item<0>(it, a, scr, lane, v);
        while (it < C9) {
#pragma unroll
            for (int i = 0; i < 32; ++i) scr[(2 * i + (lane >> 5)) * 33 + (lane & 31)] = v[i];
            asm volatile("s_waitcnt lgkmcnt(0)" ::: "memory");
            const int nxt = it + NGW;
            if (nxt < C9) tr_matrix_item<0>(nxt, a, scr, lane, v);
            tr_matrix_item<1>(it, a, scr, lane, v);
            it = nxt;
        }
    }
    __syncthreads();
    {
        LAS float* cact = (LAS float*)lds; LAS float* red = (LAS float*)(lds + 65536);
        const float* c = a->in[1];
        for (int i = tid; i < 16384; i += 512) { const float v = c[i]; cact[i] = v / (1.0f + __expf(-v)); }
        __syncthreads();
        float* mod = (float*)(ws + WS_MOD);
        for (int u = blockIdx.x; u < 768; u += G) {
            const int l = u / 384, r_ = u % 384, cgp = r_ >> 2, kq = r_ & 3, col = cgp * 64 + lane;
            float accv[16];
#pragma unroll
            for (int b = 0; b < 16; ++b) accv[b] = 0.f;
            const int kb0 = kq * 256 + wave * 32;
            const float* w = a->in[4] + (size_t)l * 1024 * 6144 + (size_t)kb0 * 6144 + col;
            float wv[32];
#pragma unroll
            for (int k = 0; k < 32; ++k) wv[k] = __builtin_nontemporal_load(w + (size_t)k * 6144);
#pragma unroll
            for (int k = 0; k < 32; ++k) {
#pragma unroll
                for (int b = 0; b < 16; ++b) accv[b] = fmaf(cact[b * 1024 + kb0 + k], wv[k], accv[b]); }
#pragma unroll
            for (int b = 0; b < 16; ++b) red[(wave * 16 + b) * 64 + lane] = accv[b];
            __syncthreads();
            for (int o = tid; o < 1024; o += 512) { const int b = o >> 6, cc = o & 63; float s = 0.f;
#pragma unroll
                for (int kg = 0; kg < 8; ++kg) s += red[(kg * 16 + b) * 64 + cc];
                if (kq == 0) s += a->in[5][l * 6144 + cgp * 64 + cc];
                atomicAdd(&mod[(size_t)(l * 16 + b) * 6144 + cgp * 64 + cc], s); }
            __syncthreads();
        }
    }
    {
        const size_t gt = (size_t)blockIdx.x * 512 + tid, NT_ = (size_t)G * 512;
        const int* pos = (const int*)a->in[2];
        f32x2* tab = (f32x2*)(ws + WS_R3);
        for (size_t idx = gt; idx < (size_t)T_TOK * 128; idx += NT_) { const int t = (int)(idx >> 7), j = (int)(idx & 127);
            const float ang = (float)pos[t] * INVF_RET[j]; float s, c; sincos_f(ang, s, c);
            tab[idx] = (f32x2){c, s}; }
        float* z1 = (float*)(ws + WS_SSQQ); float* z2 = (float*)(ws + WS_SSQKV); float* z3 = (float*)(ws + WS_GN);
        for (size_t idx = gt; idx < (size_t)T_TOK; idx += NT_) { z1[idx] = 0.f; z2[idx] = 0.f; }
        for (size_t idx = gt; idx < (size_t)T_TOK * 8; idx += NT_) z3[idx] = 0.f;
        if (gt < 8) { const float x = (gt < 4) ? a->in[7][gt] : a->in[8][gt - 4]; ((float*)(ws + WS_DEC))[gt] = -log1pf(expf(-x)) * 1.4426950408889634f; }
    }
}

struct RowJob { const float* xin; const bf16_t* y; const float* wpost; const float* gate; float* xout; const float* wpre; const float* sc; const float* sh; bf16_t* hdn; int mla_tab; };
__device__ __forceinline__ void row_phase(const RowJob& R, ArgsP a, int G, const int tid_in) {
    int tid = threadIdx.x; asm volatile("" : "+v"(tid)); (void)tid_in;
    const int lane = tid & 63, wave = tid >> 6;
    const int gw = blockIdx.x * 8 + wave, NGW = G * 8;
    constexpr int RPW = 16;
    for (int chunk = gw; chunk < T_TOK / RPW; chunk += NGW) {
        const int row0 = chunk * RPW, b = row0 >> 11;
        f32x4 A1[4], B1[4], SH[4];
#pragma unroll
        for (int j = 0; j < 4; ++j) {
            if (R.y) { const f32x4 w = ((const f32x4*)R.wpost)[lane + 64 * j], g = ((const f32x4*)(R.gate + (size_t)b * 6144))[lane + 64 * j]; A1[j] = w * g; }
            else A1[j] = (f32x4){0.f, 0.f, 0.f, 0.f};
            if (R.hdn) { const f32x4 w = ((const f32x4*)R.wpre)[lane + 64 * j], sc = ((const f32x4*)(R.sc + (size_t)b * 6144))[lane + 64 * j]; B1[j] = w * (1.0f + sc); SH[j] = ((const f32x4*)(R.sh + (size_t)b * 6144))[lane + 64 * j]; }
            else { B1[j] = (f32x4){0.f, 0.f, 0.f, 0.f}; SH[j] = B1[j]; }
        }
        f32x4 v[4], vn[4]; u32x2 yw[4], ywn[4];
        {
            const f32x4* xr = (const f32x4*)(R.xin + (size_t)row0 * DM) + lane;
#pragma unroll
            for (int j = 0; j < 4; ++j) v[j] = __builtin_nontemporal_load(xr + 64 * j);
            if (R.y) { const u32x2* yr = (const u32x2*)(R.y + (size_t)row0 * DM) + lane;
#pragma unroll
                for (int j = 0; j < 4; ++j) yw[j] = __builtin_nontemporal_load(yr + 64 * j); }
        }
        for (int rr = 0; rr < RPW; ++rr) {
            const int row = row0 + rr;
            if (rr + 1 < RPW) {
                const f32x4* xr = (const f32x4*)(R.xin + (size_t)(row + 1) * DM) + lane;
#pragma unroll
                for (int j = 0; j < 4; ++j) vn[j] = __builtin_nontemporal_load(xr + 64 * j);
                if (R.y) { const u32x2* yr = (const u32x2*)(R.y + (size_t)(row + 1) * DM) + lane;
#pragma unroll
                    for (int j = 0; j < 4; ++j) ywn[j] = __builtin_nontemporal_load(yr + 64 * j); }
            }
            if (R.y) {
                f32x4 y[4]; float s = 0.f;
#pragma unroll
                for (int j = 0; j < 4; ++j) { const u32x2 w = yw[j]; y[j][0] = bf2f(w.x & 0xffffu); y[j][1] = bf2f(w.x >> 16); y[j][2] = bf2f(w.y & 0xffffu); y[j][3] = bf2f(w.y >> 16);
                    s += (y[j][0] * y[j][0] + y[j][1] * y[j][1]) + (y[j][2] * y[j][2] + y[j][3] * y[j][3]); }
                const float rstd = 1.0f / sqrtf(wave_sum(s) * (1.0f / DM) + 1e-6f);
                f32x4* xo = (f32x4*)(R.xout + (size_t)row * DM) + lane;
#pragma unroll
                for (int j = 0; j < 4; ++j) { v[j] = v[j] + (y[j] * rstd) * A1[j]; __builtin_nontemporal_store(v[j], xo + 64 * j); }
            }
            if (R.hdn) {
                float s = 0.f;
#pragma unroll
                for (int j = 0; j < 4; ++j) s += (v[j][0] * v[j][0] + v[j][1] * v[j][1]) + (v[j][2] * v[j][2] + v[j][3] * v[j][3]);
                const float rstd = 1.0f / sqrtf(wave_sum(s) * (1.0f / DM) + 1e-6f);
                u32x2* ho = (u32x2*)(R.hdn + (size_t)row * DM) + lane;
#pragma unroll
                for (int j = 0; j < 4; ++j) { const f32x4 h = (v[j] * rstd) * B1[j] + SH[j]; u32x2 o; o.x = cvt_pk_bf16(h[0], h[1]); o.y = cvt_pk_bf16(h[2], h[3]); ho[64 * j] = o; }
            }
#pragma unroll
            for (int j = 0; j < 4; ++j) { v[j] = vn[j]; yw[j] = ywn[j]; }
        }
    }
    if (R.mla_tab) {
        const size_t gt = (size_t)blockIdx.x * 512 + tid, NT_ = (size_t)G * 512;
        const int* pos = (const int*)a->in[2];
        f32x2* tab = (f32x2*)(a->ws + WS_R3 + 64 * MiB);
        for (size_t idx = gt; idx < (size_t)T_TOK * 32; idx += NT_) { const int t = (int)(idx >> 5), j = (int)(idx & 31);
            const float ang = (float)pos[t] * INVF_MLA[j]; float s, c; sincos_f(ang, s, c);
            tab[idx] = (f32x2){c, s}; }
    }
}


__device__ __forceinline__ void mla_table_half(ArgsP a, int G) {
    int tid = threadIdx.x; asm volatile("" : "+v"(tid));
    const int half = (G % 2 == 0) ? G / 2 : 0;
    if ((int)blockIdx.x < half) return;
    const size_t gt = (size_t)((int)blockIdx.x - half) * 512 + tid, NT_ = (size_t)(G - half) * 512;
    const int* pos = (const int*)a->in[2];
    f32x2* tab = (f32x2*)(a->ws + WS_R3 + 64 * MiB);
    for (size_t idx = gt; idx < (size_t)T_TOK * 32; idx += NT_) { const int t = (int)(idx >> 5), j = (int)(idx & 31);
        const float ang = (float)pos[t] * INVF_MLA[j]; float s, c; sincos_f(ang, s, c);
        tab[idx] = (f32x2){c, s}; }
}

#define XB_TMO      128
#define XB_XCNT(j)  (256  + 64 * (j))
#define XB_XSUB(j)  (1280 + 64 * (j))
#define XB_XGEN(j)  (2304 + 64 * (j))
#define XB_TOP      3328
#define XB_TOPGEN   3392
#define XCD_BAR_WORDS 3456
#define XB_SPIN_CAP (1u << 21)
__device__ __forceinline__ unsigned xb_ld(unsigned* p)              { return __hip_atomic_load(p, __ATOMIC_RELAXED, __HIP_MEMORY_SCOPE_AGENT); }
__device__ __forceinline__ unsigned xb_add(unsigned* p, unsigned v) { return __hip_atomic_fetch_add(p, v, __ATOMIC_RELAXED, __HIP_MEMORY_SCOPE_AGENT); }
__device__ __forceinline__ unsigned xb_xcc_id() { return (unsigned)__builtin_amdgcn_s_getreg((3 << 11) | 20) & 0xFu; }
#define XB_SPIN(cond, bar) do { unsigned _sp = 0; while (cond) { __builtin_amdgcn_s_sleep(1); \
    if ((++_sp & 255u) == 0u) { if (xb_ld(&(bar)[XB_TMO])) break; if (_sp > XB_SPIN_CAP) { atomicAdd(&(bar)[XB_TMO], 1u); break; } } } } while (0)
struct XcdBarrier { unsigned* bar; unsigned x; volatile LAS unsigned* st; };
__device__ __forceinline__ void xcd_barrier_complete(unsigned* bar, unsigned x, unsigned& nloc, unsigned& nx) {
    const unsigned G = gridDim.x * gridDim.y * gridDim.z;
    unsigned sum, cnt, mine, sp = 0u;
    for (;;) {
        sum = 0u; cnt = 0u; mine = 0u;
#pragma unroll
        for (unsigned j = 0; j < 16; ++j) { const unsigned c = xb_ld(&bar[XB_XCNT(j)]); sum += c; cnt += (c > 0u) ? 1u : 0u; mine = (j == x) ? c : mine; }
        if (sum == G) break;
        __builtin_amdgcn_s_sleep(1);
        if ((++sp & 255u) == 0u) { if (xb_ld(&bar[XB_TMO])) break; if (sp > XB_SPIN_CAP) { atomicAdd(&bar[XB_TMO], 1u); break; } }
    }
    nloc = mine > 0u ? mine : 1u; nx = cnt > 0u ? cnt : 1u;
}
__device__ __forceinline__ void xcd_barrier(const XcdBarrier& b) {
    asm volatile("s_waitcnt vmcnt(0)" ::: "memory");
    __syncthreads();
    if (threadIdx.x == 0) {
        unsigned* bar = b.bar;
        __builtin_amdgcn_s_waitcnt(0);
        unsigned nloc = b.st[0], nx = b.st[1];
        if (nloc == 0u) { xcd_barrier_complete(bar, b.x, nloc, nx); b.st[0] = nloc; b.st[1] = nx; }
        const unsigned old = xb_add(&bar[XB_XSUB(b.x)], 1u);
        const unsigned gen = old / nloc;
        if (old + 1u == (gen + 1u) * nloc) {
            __builtin_amdgcn_fence(__ATOMIC_RELEASE, "agent");
            asm volatile("s_waitcnt vmcnt(0)" ::: "memory");
            const unsigned og = xb_add(&bar[XB_TOP], 1u);
            const unsigned tg = og / nx;
            if (og + 1u == (tg + 1u) * nx) xb_add(&bar[XB_TOPGEN], 1u);
            else XB_SPIN(xb_ld(&bar[XB_TOPGEN]) == tg, bar);
            __builtin_amdgcn_fence(__ATOMIC_ACQUIRE, "agent");
            xb_add(&bar[XB_XGEN(b.x)], 1u);
            asm volatile("s_waitcnt vmcnt(0)" ::: "memory");
        } else {
            XB_SPIN(xb_ld(&bar[XB_XGEN(b.x)]) == gen, bar);
            __builtin_amdgcn_fence(__ATOMIC_ACQUIRE, "agent");
            asm volatile("s_waitcnt vmcnt(0)" ::: "memory");
        }
    }
    __syncthreads();
}

constexpr int NJOBS = 27;
enum { K_PREP = 0, K_ROW = 1, K_GEMM = 2, K_ATTN = 3, K_NONE = 5 };
__host__ __device__ __forceinline__ int job_sync_after(int j) { return !(j == 2 || (j >= 8 && j <= 11) || j == 19 || j == 26); }

__device__ __forceinline__ RowJob make_row(int j, ArgsP ap) {
    unsigned char* ws = ap->ws; const float* mod = (const float*)(ws + WS_MOD); const float* normw = ap->in[3]; float* out = ap->out;
    const int k = (j == 1) ? 0 : (j == 14) ? 1 : (j == 17) ? 2 : (j == 23) ? 3 : 4;
    RowJob r;
    r.xin = (k <= 1) ? ap->in[0] : (const float*)out;
    r.y = (k == 0) ? (const bf16_t*)nullptr : (const bf16_t*)(ws + ((k == 3) ? WS_R1 : WS_R3));
    r.wpost = normw + (2 * k - 1) * 1024;
    r.gate = mod + ((k >= 3) ? 16 * 6144 : 0) + ((k & 1) ? 2 : 5) * 1024;
    r.xout = out;
    r.wpre = normw + (2 * k) * 1024;
    r.sc = mod + ((k >= 2) ? 16 * 6144 : 0) + ((k & 1) ? 4 : 1) * 1024;
    r.sh = mod + ((k >= 2) ? 16 * 6144 : 0) + ((k & 1) ? 3 : 0) * 1024;
    r.hdn = (k == 4) ? (bf16_t*)nullptr : (bf16_t*)(ws + WS_HDN);
    r.mla_tab = 0;
    return r;
}
__device__ __forceinline__ GemmJob make_gemm(int j, unsigned char* ws, bf16_t* outb) {
    GemmJob g{}; g.zdiv = 1; g.nZ = 1;
    bf16_t* HDN = (bf16_t*)(ws + WS_HDN);
    bf16_t* R1 = (bf16_t*)(ws + WS_R1); bf16_t* R2 = (bf16_t*)(ws + WS_R2); bf16_t* R3 = (bf16_t*)(ws + WS_R3);
    if (j == 2) {
        g.A = HDN; g.lda = 1024; g.Bt = (const bf16_t*)(ws + WS_RWIN); g.ldb = 1024; g.K = 1024; g.nM = 128; g.nN = 8; g.epi = EPI_RETQK;
    } else if (j == 3) {
        g.A = (const bf16_t*)(ws + WS_RWIN) + (size_t)2048 * 1024; g.lda = 1024; g.Bt = HDN; g.ldb = 1024; g.K = 1024; g.nM = 8; g.nN = 8; g.nZ = 16; g.zBh = (long)2048 * 1024; g.epi = EPI_STORE; g.var = 0;
    } else if (j >= 4 && j <= 7) {
        const int grp = (j - 4) >> 1;
        if (((j - 4) & 1) == 0) {
            g.A = R1 + (size_t)grp * 8 * 2 * 2048 * 1024; g.lda = 1024; g.zdiv = 4; g.zAh = (long)2 * 2048 * 1024; g.zAl = 256;
            g.Bt = g.A + (size_t)2048 * 1024; g.ldb = 1024; g.zBh = g.zAh; g.zBl = 256;
            g.K = 256; g.nM = 8; g.nN = 8; g.nZ = 32; g.epi = EPI_SDECAY; g.var = grp;
        } else {
            g.A = R3; g.lda = 2048; g.zdiv = 16; g.zAh = (long)(outb - R3); g.zAl = (long)2048 * 2048;
            g.Bt = R2 + (size_t)grp * 8 * 2048 * 2048; g.ldb = 2048; g.zBh = (long)16 * 512 * 2048; g.zBl = (long)512 * 2048;
            g.K = 2048; g.nM = 8; g.nN = 2; g.nZ = 32; g.epi = EPI_OY; g.var = grp * 8;
        }
    } else if (j == 12) {
        g.A = HDN; g.lda = 1024; g.Bt = (const bf16_t*)(ws + WS_RWIN) + (size_t)4096 * 1024; g.ldb = 1024; g.K = 1024; g.nM = 128; g.nN = 8; g.epi = EPI_GATE;
    } else if (j == 13) {
        g.A = R1; g.lda = 2048; g.Bt = (const bf16_t*)(ws + WS_RWOUT); g.ldb = 2048; g.K = 2048; g.nM = 128; g.nN = 4; g.epi = EPI_STORE; g.var = 1;
    } else if (j == 15 || j == 24) {
        const int l = (j == 24);
        g.A = HDN; g.lda = 1024; g.Bt = (const bf16_t*)(ws + WS_W1) + (size_t)l * 4096 * 1024; g.ldb = 1024; g.K = 1024; g.nM = 128; g.nN = 16; g.epi = EPI_RELU2; g.var = 3;
    } else if (j == 16 || j == 25) {
        const int l = (j == 25);
        g.A = R1; g.lda = 4096; g.Bt = (const bf16_t*)(ws + WS_W2) + (size_t)l * 1024 * 4096; g.ldb = 4096; g.K = 4096; g.nM = 128; g.nN = 4; g.epi = EPI_STORE; g.var = 1; g.rev = 1;
    } else if (j == 18) {
        g.A = HDN; g.lda = 1024; g.Bt = (const bf16_t*)(ws + WS_MWIN); g.ldb = 1024; g.K = 1024; g.nM = 128; g.nN = 3; g.epi = EPI_WIN;
    } else if (j == 19) {
        g.A = R3; g.lda = 768; g.Bt = (const bf16_t*)(ws + WS_MWUQ); g.ldb = 384; g.K = 384; g.nM = 128; g.nN = 6; g.epi = EPI_UQ;
    } else if (j == 20) {
        g.A = R3 + 384; g.lda = 768; g.Bt = (const bf16_t*)(ws + WS_MWUKV); g.ldb = 256; g.K = 256; g.nM = 128; g.nN = 8; g.epi = EPI_UKV;
    } else {
        g.A = (const bf16_t*)(ws + WS_R3 + 64 * MiB); g.lda = 1024; g.Bt = (const bf16_t*)(ws + WS_MWOUT); g.ldb = 1024; g.K = 1024; g.nM = 128; g.nN = 4; g.epi = EPI_STORE; g.var = 2;
    }
    return g;
}

__global__ void __launch_bounds__(512, 2) fwd_megakernel(Args a) {
    extern __shared__ __attribute__((aligned(16))) unsigned char lds_raw[];
    const int G = gridDim.x;
    const int j_lo = a.j_lo, j_hi = a.j_hi;
    volatile LAS unsigned* xb_st = (volatile LAS unsigned*)((LAS unsigned char*)lds_raw + 131072 + 64);
    if (threadIdx.x < 2) xb_st[threadIdx.x] = 0u;
    __syncthreads();
    if (threadIdx.x == 0) (void)xb_add((unsigned*)(a.ws + WS_BAR) + XB_XCNT(xb_xcc_id()), 1u);
#if PROBE
    unsigned long long tprev = __builtin_amdgcn_s_memrealtime(); unsigned tc0 = 0, tc1 = 0, tc2 = 0, tc3 = 0, tc4 = 0, tc5 = 0, tc6 = 0;
#endif
    for (int j = j_lo; j < j_hi; ++j) {
        const int tidl = 0;
        ArgsP ap = (ArgsP)__builtin_amdgcn_kernarg_segment_ptr(); asm volatile("" : "+s"(ap));
        int kind;
        if (j == 0) kind = K_PREP;
        else if (j == 1 || j == 14 || j == 17 || j == 23 || j == 26) kind = K_ROW;
        else if (j == 21) kind = K_ATTN;
        else if (j >= 8 && j <= 11) kind = K_NONE;
        else kind = K_GEMM;
        switch (kind) {
#ifndef NO_PREP
        case K_PREP: prep_phase(ap, (char*)lds_raw, G, tidl); break;
#endif
#ifndef NO_ROW
        case K_ROW: { const RowJob r = make_row(j, ap); row_phase(r, ap, G, tidl); } break;
#endif
#ifndef NO_GEMM
        case K_GEMM: { const GemmJob g = make_gemm(j, ap->ws, (bf16_t*)ap->out); Sched S; S.init(g.nZ, g.nM, g.nN, G, (int)blockIdx.x, g.rev); gemm_phase((LAS unsigned char*)lds_raw, g, S, ap, tidl); } break;
#endif
#ifndef NO_ATTN
        case K_ATTN: {
            unsigned char* ws = ap->ws;
            const bf16_t* Q1 = (const bf16_t*)(ws + WS_R1); const bf16_t* K1 = Q1 + (size_t)T_TOK * 1536; const bf16_t* V1 = Q1 + (size_t)2 * T_TOK * 1536;
            bf16_t* O = (bf16_t*)(ws + WS_R3 + 64 * MiB);
            const int vcu = (G % 8 == 0) ? ((int)blockIdx.x % 8) * (G / 8) + (int)blockIdx.x / 8 : (int)blockIdx.x;
            for (int un = vcu; un < NB * 8 * 8; un += G) {
                const int bh = un >> 3, qb = un & 7, b = bh >> 3, h = bh & 7;
                mla::attn_unit(Q1 + ((size_t)(b * 2048 + qb * 256) * 1536 + h * 192), K1 + ((size_t)b * 2048 * 1536 + h * 192), V1 + ((size_t)b * 2048 * 1024 + h * 128),
                               O + ((size_t)(b * 2048 + qb * 256) * 1024 + h * 128), (char*)lds_raw, tidl);
            }
        } break;
#endif
        default: break;
        }
        if (j == 18) mla_table_half(ap, G);
#if PROBE
        __syncthreads(); cg::this_grid().sync();
        { const unsigned long long tn = __builtin_amdgcn_s_memrealtime(); const unsigned dt = (unsigned)(tn - tprev); tprev = tn;
          if (kind == K_PREP) tc0 += dt; else if (kind == K_ROW) tc1 += dt; else if (kind == K_ATTN) tc2 += dt;
          else if (j >= 4 && j <= 11) tc3 += dt; else if (j == 15 || j == 16 || j == 24 || j == 25) tc4 += dt; else tc5 += dt;
          if ((PROBE_MASK >> j) & 1u) tc6 += dt; }
#else
        if (job_sync_after(j) && j + 1 < j_hi) {
            if (j_hi < 0) { __syncthreads(); cg::this_grid().sync(); }
            { XcdBarrier xb; xb.bar = (unsigned*)(ap->ws + WS_BAR); xb.x = xb_xcc_id(); xb.st = xb_st; xcd_barrier(xb); }
        }
        else __syncthreads();
#endif
    }
#if PROBE
    if (blockIdx.x == 0) {
        const unsigned ta = (PROBE == 1) ? tc1 : (PROBE == 2) ? tc2 : (PROBE == 3) ? tc3 : (PROBE == 4) ? tc4 : (PROBE == 5) ? tc5 : (PROBE == 7) ? tc6 : tc0;
        float* out = a.out;
        for (int i = threadIdx.x; i < (1 << 16); i += 512) out[i] += (float)ta * 5.06e-7f;
    }
#endif
}

extern "C" void kernel_launch(void* const* d_in, const int* in_sizes, int n_in, void* d_out, int out_size, void* d_ws, size_t ws_size, hipStream_t stream) {
    static int grid = 0;
    if (grid == 0) {
        if (n_in != 19 || out_size != T_TOK * DM || ws_size < WS_END) { fprintf(stderr, "kernel_launch: unexpected shapes n_in %d out %d ws %zu (need %zu)\n", n_in, out_size, ws_size, (size_t)WS_END); grid = -1; return; }
        int dev = 0, cus = 0, per_cu = 0;
        hipGetDevice(&dev); hipDeviceGetAttribute(&cus, hipDeviceAttributeMultiprocessorCount, dev);
        if (hipFuncSetAttribute((const void*)fwd_megakernel, hipFuncAttributeMaxDynamicSharedMemorySize, LDS_BYTES) != hipSuccess) { fprintf(stderr, "kernel_launch: hipFuncSetAttribute failed\n"); grid = -1; return; }
        if (hipOccupancyMaxActiveBlocksPerMultiprocessor(&per_cu, (const void*)fwd_megakernel, 512, LDS_BYTES) != hipSuccess || per_cu < 1) { fprintf(stderr, "kernel_launch: occupancy query says %d\n", per_cu); per_cu = 1; }
        (void)hipGetLastError();
        grid = cus * 1;
        fprintf(stderr, "kernel_launch: grid %d (cus %d, per_cu %d)\n", grid, cus, per_cu);
    }
    if (grid < 0) return;
    if (hipMemsetAsync((char*)d_ws + WS_MOD, 0, WS_BAR + (size_t)XCD_BAR_WORDS * 4, stream) != hipSuccess) { fprintf(stderr, "kernel_launch: hipMemsetAsync failed\n"); return; }
    Args a{};
    for (int i = 0; i < 19; ++i) a.in[i] = (const float*)d_in[i];
    a.out = (float*)d_out; a.ws = (unsigned char*)d_ws;
#if MULTI_LAUNCH
    int lo = 0;
    for (int j = 0; j < NJOBS; ++j) {
        if (job_sync_after(j) || j == NJOBS - 1) {
            a.j_lo = lo; a.j_hi = j + 1; lo = j + 1;
            hipLaunchKernelGGL(fwd_megakernel, dim3(grid), dim3(512), LDS_BYTES, stream, a);
        }
    }
#else
    a.j_lo = 0; a.j_hi = NJOBS;
    void* args[] = {&a};
    hipError_t e = hipLaunchCooperativeKernel((const void*)fwd_megakernel, dim3(grid), dim3(512), args, LDS_BYTES, stream);
    if (e != hipSuccess) fprintf(stderr, "cooperative launch failed: %s (grid %d)\n", hipGetErrorString(e), grid);
#endif
}
```
